# Optimizing an MI355X kernel written in HIP

```python
import jax, jax.numpy as jnp
from jax import lax
import numpy as np

D_MODEL = 2048
BATCH = 8
SEQ = 2048
DEPTH = 1

HEAD_DIM = 64
ATTN_WIDTH = D_MODEL // 2
ATTN_Q_HEADS = ATTN_WIDTH // HEAD_DIM
ATTN_KV_HEADS = 4
KV_WIDTH = ATTN_KV_HEADS * HEAD_DIM
WINDOW = 128
BLOCK = 128
RWKV_WIDTH = D_MODEL - ATTN_WIDTH
RWKV_HEADS = RWKV_WIDTH // HEAD_DIM
DECAY_LORA = 64
ICLR_LORA = 64
MIX_WIDTH = ATTN_WIDTH + RWKV_WIDTH
ATTN_SIZES = [ATTN_WIDTH, KV_WIDTH, KV_WIDTH, ATTN_WIDTH]
RWKV_SHIFT_SIZES = [RWKV_WIDTH, RWKV_WIDTH, RWKV_WIDTH, DECAY_LORA, ICLR_LORA]
RWKV_SHIFT_COLS = sum(RWKV_SHIFT_SIZES)
ATTN_COLS = sum(ATTN_SIZES)
RWKV_COLS = RWKV_SHIFT_COLS + RWKV_WIDTH
IN_COLS = ATTN_COLS + RWKV_COLS
RMS_EPS = 1e-6
GN_EPS = 64e-5
NEG_BIG = -1e30

kernel_name = "hymba_swa_sink_rwkv7_hybrid"


def _split(x, sizes):
    offs = np.cumsum(sizes)[:-1].tolist()
    return jnp.split(x, offs, axis=-1)


def _rms_norm(x, g):
    xf = x.astype(jnp.float32)
    y = xf * lax.rsqrt(jnp.mean(xf * xf, axis=-1, keepdims=True) + RMS_EPS)
    return (y * g.astype(jnp.float32)).astype(x.dtype)


def _sliding_window_attention(q, k, v, sinks):
    B, T = q.shape[0], q.shape[1]
    nb = T // BLOCK
    G = ATTN_Q_HEADS // ATTN_KV_HEADS
    qb = q.reshape(B, nb, BLOCK, ATTN_KV_HEADS, G, HEAD_DIM)
    kb = k.reshape(B, nb, BLOCK, ATTN_KV_HEADS, HEAD_DIM)
    vb = v.reshape(B, nb, BLOCK, ATTN_KV_HEADS, HEAD_DIM)
    pad = ((0, 0), (1, 0), (0, 0), (0, 0), (0, 0))
    kcat = jnp.concatenate([jnp.pad(kb, pad)[:, :-1], kb], axis=2)
    vcat = jnp.concatenate([jnp.pad(vb, pad)[:, :-1], vb], axis=2)
    scale = HEAD_DIM ** -0.5
    s = jnp.einsum('bnqhgd,bnshd->bnhgqs', qb, kcat).astype(jnp.float32) * scale
    qi = jnp.arange(BLOCK)[:, None]
    si = jnp.arange(2 * BLOCK)[None, :]
    rel = si - BLOCK - qi
    in_win = (rel <= 0) & (rel > -WINDOW)
    has_prev = (jnp.arange(nb)[:, None, None] > 0) | (si[None] >= BLOCK)
    valid = in_win[None] & has_prev
    s = jnp.where(valid[None, :, None, None], s, NEG_BIG)
    sink = sinks.astype(jnp.float32).reshape(ATTN_KV_HEADS, G)[None, None, :, :, None, None]
    sink = jnp.broadcast_to(sink, s.shape[:-1] + (1,))
    p = jax.nn.softmax(jnp.concatenate([s, sink], axis=-1), axis=-1)[..., :-1]
    o = jnp.einsum('bnhgqs,bnshd->bnqhgd', p.astype(v.dtype), vcat)
    return o.reshape(B, T, ATTN_WIDTH)


def _rwkv7_step(S, inp):
    r_t, w_t, k_t, v_t, a_t, b_t = inp
    sa = jnp.einsum('bhvk,bhk->bhv', S, a_t)
    S = S * w_t[:, :, None, :] + sa[..., None] * b_t[:, :, None, :] + v_t[..., None] * k_t[:, :, None, :]
    y = jnp.einsum('bhvk,bhk->bhv', S, r_t)
    return S, y


def _rwkv7_time_mix(p, mu, w0, w_up, a0, a_up, k_k, k_a, r_k, ln_w, ln_b):
    B, T = p.shape[0], p.shape[1]
    prev = jnp.pad(p, ((0, 0), (1, 0), (0, 0)))[:, :-1]
    p = p + (prev - p) * mu
    r, k, v, wd, ad = _split(p, RWKV_SHIFT_SIZES)
    w = -jax.nn.softplus(-(w0 + jnp.tanh(wd) @ w_up)) - 0.5
    decay = jnp.exp(-jnp.exp(w.astype(jnp.float32)))
    a = jax.nn.sigmoid(a0 + ad @ a_up)
    hs = (B, T, RWKV_HEADS, HEAD_DIM)
    kk = (k * k_k).reshape(hs).astype(jnp.float32)
    kk = kk * lax.rsqrt(jnp.maximum(jnp.sum(kk * kk, -1, keepdims=True), 1e-24))
    k = k * (1 + (a - 1) * k_a)
    rh = r.reshape(hs).astype(jnp.float32)
    kh = k.reshape(hs).astype(jnp.float32)
    vh = v.reshape(hs).astype(jnp.float32)
    ah = a.reshape(hs).astype(jnp.float32)
    xs = tuple(jnp.moveaxis(t, 1, 0) for t in (rh, decay.reshape(hs), kh, vh, -kk, kk * ah))
    S0 = jnp.zeros((B, RWKV_HEADS, HEAD_DIM, HEAD_DIM), jnp.float32)
    _, ys = lax.scan(_rwkv7_step, S0, xs)
    y = jnp.moveaxis(ys, 0, 1)
    mean = jnp.mean(y, -1, keepdims=True)
    var = jnp.mean(jnp.square(y - mean), -1, keepdims=True)
    y = ((y - mean) * lax.rsqrt(var + GN_EPS)).reshape(B, T, RWKV_WIDTH)
    y = y * ln_w.astype(jnp.float32) + ln_b.astype(jnp.float32)
    bonus = jnp.sum(rh * kh * r_k.astype(jnp.float32), -1, keepdims=True) * vh
    y = y + bonus.reshape(B, T, RWKV_WIDTH)
    return y.astype(p.dtype)


def setup_inputs(seed: int = 0) -> dict:
    key = jax.random.key(seed)
    ks = jax.random.split(key, 20)
    f = jnp.float32
    L, D = DEPTH, D_MODEL
    return {
        "x": jax.random.normal(ks[0], (BATCH, SEQ, D), f),
        "c": jax.random.normal(ks[1], (BATCH, D), f),
        "w_ada": jax.random.normal(ks[2], (L, D, 3 * D), f) * (0.5 * D ** -0.5),
        "b_ada": jax.random.normal(ks[3], (L, 3 * D), f) * 0.02,
        "pre_norm_g": 1.0 + 0.05 * jax.random.normal(ks[4], (L, D), f),
        "post_norm_g": 1.0 + 0.05 * jax.random.normal(ks[5], (L, D), f),
        "w_in": jax.random.normal(ks[6], (L, D, IN_COLS), f) * D ** -0.5,
        "w_out": jax.random.normal(ks[7], (L, MIX_WIDTH, D), f) * MIX_WIDTH ** -0.5,
        "attn_sinks": jax.random.normal(ks[8], (L, ATTN_Q_HEADS), f),
        "rwkv_mu": jax.random.uniform(ks[9], (L, RWKV_SHIFT_COLS), f),
        "rwkv_w0": jax.random.uniform(ks[10], (L, RWKV_WIDTH), f, -6.0, 0.0),
        "rwkv_w_up": jax.random.normal(ks[11], (L, DECAY_LORA, RWKV_WIDTH), f) * 0.1,
        "rwkv_a0": jax.random.normal(ks[12], (L, RWKV_WIDTH), f) * 0.1,
        "rwkv_a_up": jax.random.normal(ks[13], (L, ICLR_LORA, RWKV_WIDTH), f) * 0.1,
        "rwkv_k_k": 0.85 + 0.1 * jax.random.normal(ks[14], (L, RWKV_WIDTH), f),
        "rwkv_k_a": 1.0 + 0.1 * jax.random.normal(ks[15], (L, RWKV_WIDTH), f),
        "rwkv_r_k": jax.random.normal(ks[16], (L, RWKV_HEADS, HEAD_DIM), f) * 0.1,
        "rwkv_ln_w": 1.0 + 0.05 * jax.random.normal(ks[17], (L, RWKV_WIDTH), f),
        "rwkv_ln_b": 0.02 * jax.random.normal(ks[18], (L, RWKV_WIDTH), f),
    }


def reference(x, c, w_ada, b_ada, pre_norm_g, post_norm_g, w_in, w_out, attn_sinks,
              rwkv_mu, rwkv_w0, rwkv_w_up, rwkv_a0, rwkv_a_up, rwkv_k_k, rwkv_k_a,
              rwkv_r_k, rwkv_ln_w, rwkv_ln_b):
    B, T = x.shape[0], x.shape[1]
    for l in range(DEPTH):
        mod = jax.nn.silu(c) @ w_ada[l] + b_ada[l]
        shift, scale, gate = jnp.split(mod, 3, axis=-1)
        h = _rms_norm(x, pre_norm_g[l]) * (1 + scale[:, None]) + shift[:, None]
        proj = h @ w_in[l]
        p_attn, p_rwkv = proj[..., :ATTN_COLS], proj[..., ATTN_COLS:]
        q, ka, va, ga = _split(p_attn, ATTN_SIZES)
        y_attn = _sliding_window_attention(
            q.reshape(B, T, ATTN_Q_HEADS, HEAD_DIM),
            ka.reshape(B, T, ATTN_KV_HEADS, HEAD_DIM),
            va.reshape(B, T, ATTN_KV_HEADS, HEAD_DIM),
            attn_sinks[l]) * jax.nn.silu(ga)
        p_shift, gr = p_rwkv[..., :RWKV_SHIFT_COLS], p_rwkv[..., RWKV_SHIFT_COLS:]
        y_rwkv = _rwkv7_time_mix(p_shift, rwkv_mu[l], rwkv_w0[l], rwkv_w_up[l], rwkv_a0[l],
                                 rwkv_a_up[l], rwkv_k_k[l], rwkv_k_a[l], rwkv_r_k[l],
                                 rwkv_ln_w[l], rwkv_ln_b[l]) * jax.nn.silu(gr)
        mix = jnp.concatenate([y_attn, y_rwkv], axis=-1) @ w_out[l]
        x = x + gate[:, None] * _rms_norm(mix, post_norm_g[l])
    return x
```

```cpp
#include <hip/hip_runtime.h>
#include <hip/hip_cooperative_groups.h>
#include <cstdio>
#include <cstdint>
namespace cg = cooperative_groups;
namespace pg8 {
#define PG8_LAS __attribute__((address_space(3)))
typedef unsigned short bf16_t;
typedef short bf16x8 __attribute__((ext_vector_type(8)));
typedef float f32x4 __attribute__((ext_vector_type(4)));
typedef unsigned u32x4 __attribute__((ext_vector_type(4)));
constexpr int BM = 256, BK = 64, HALF = 128, HTB = HALF * BK * 2  , STAGE_BYTES = 8 * HTB, NXCD = 8, WGM = 8;

__host__ __device__ __forceinline__ int lds_byte(int r, int c) { const int st = (r >> 4) * 2 + (c >> 5), rr = r & 15, cc = c & 31, ob = rr * 64 + cc * 2; return st * 1024 + (ob ^ (((ob >> 9) & 1) << 5)); }
__host__ __device__ __forceinline__ void stage_rc(int b, int& R, int& C) { const int st = b / 1024, sb = b % 1024, swz = sb ^ (((sb >> 9) & 1) << 5); R = (st >> 1) * 16 + swz / 64; C = (st & 1) * 32 + (swz % 64) / 2; }
__host__ __device__ __forceinline__ int perm32(int rho) { const int n = rho >> 4, i = rho & 15; return 8 * (i >> 2) + 4 * n + (i & 3); }

struct Unit { int pm, pn; };
struct Gemm { const bf16_t* A; const bf16_t* Bt; int M, N, K; };

struct StaticOrder {
    int nM, nN, nwg, G, c;
    __host__ __device__ void init(int M, int N, int G_, int c_) { nM = M / BM; nN = N / BM; nwg = nM * nN; G = G_; c = c_; }
    __host__ __device__ bool next(int i, Unit& u) const {
        const long L = (long)i * G + c; if (L >= nwg) return false;
        int wgid = (int)L; { const int q = nwg / NXCD, r = nwg % NXCD, xcd = wgid % NXCD, off = wgid / NXCD; wgid = (xcd < r ? xcd * (q + 1) : r * (q + 1) + (xcd - r) * q) + off; }
        const int nig = WGM * nN, gid = wgid / nig, fm = gid * WGM, gsz = (nM - fm) < WGM ? (nM - fm) : WGM;
        u.pm = fm + ((wgid % nig) % gsz); u.pn = (wgid % nig) / gsz; return true;
    }
    __device__ __forceinline__ void a_ready(const Unit&) const {}
    __device__ __forceinline__ void done(const Unit&) const {}
};

typedef __bf16 bf16x2n_t __attribute__((ext_vector_type(2))); typedef float f32x2n_t __attribute__((ext_vector_type(2)));
__device__ __forceinline__ unsigned cvt_pk_bf16(float lo, float hi) { const f32x2n_t v = {lo, hi}; return __builtin_bit_cast(unsigned, __builtin_convertvector(v, bf16x2n_t)); }
typedef float f32x2 __attribute__((ext_vector_type(2)));
__device__ __forceinline__ f32x2 gelu_pk(f32x2 v) {
    const f32x2 av = __builtin_elementwise_abs(v), d = av * 0.2316418882f + 1.0f;
    f32x2 t; t.x = __builtin_amdgcn_rcpf(d.x); t.y = __builtin_amdgcn_rcpf(d.y);
    f32x2 q = t * 0.5307027145f + (-0.7265760135f); q = q * t + 0.7107068705f; q = q * t + (-0.142248368f); q = q * t + 0.127414796f; q = q * t;
    const f32x2 s = (v * v) * (-0.72134752044f);
    f32x2 e; e.x = __builtin_amdgcn_exp2f(s.x); e.y = __builtin_amdgcn_exp2f(s.y);
    const f32x2 m = v * (q * e), r = v - m;
    f32x2 o; o.x = v.x < 0.f ? m.x : r.x; o.y = v.y < 0.f ? m.y : r.y; return o;
}

template <int ACT  > struct EpiBf16 {
    static constexpr bool PERM = true, AFTER_DRAIN = false; static_assert(ACT == 0 || ACT == 1, "EpiBf16: ACT is 0 (none) or 1 (gelu_pk)");
    bf16_t* O; int ldc; const float* bias; int split_cols; size_t split_stride; float scale0;
    __device__ __forceinline__ void operator()(const f32x4 (&acc)[2][2][4][2], const Unit& u, int wr, int wc, int fr, int fq) const {
        const int row0 = u.pm * BM + wr * 64 + fr; int colt = u.pn * BM; bf16_t* base = O;
        float sc = 1.f; if (split_cols) { const int t = colt / split_cols; base += (size_t)t * split_stride; colt -= t * split_cols; if (t == 0) sc = scale0; }
        const int col0 = colt + wc * 32 + 8 * fq, bcol0 = u.pn * BM + wc * 32 + 8 * fq;
        f32x4 bv[2][2];
#pragma unroll
        for (int bj = 0; bj < 2; ++bj)
#pragma unroll
            for (int n = 0; n < 2; ++n) bv[bj][n] = bias ? *(const f32x4*)(bias + bcol0 + bj * HALF + 4 * n) : (f32x4){0.f, 0.f, 0.f, 0.f};
#pragma unroll
        for (int ai = 0; ai < 2; ++ai)
#pragma unroll
            for (int m = 0; m < 4; ++m) { bf16_t* rowp = base + (size_t)(row0 + ai * HALF + m * 16) * ldc + col0;
#pragma unroll
                for (int bj = 0; bj < 2; ++bj) { f32x4 v0 = acc[ai][bj][m][0] + bv[bj][0], v1 = acc[ai][bj][m][1] + bv[bj][1];
                    if (ACT == 1) { f32x2 a = gelu_pk((f32x2){v0[0], v0[1]}), b = gelu_pk((f32x2){v0[2], v0[3]}), c = gelu_pk((f32x2){v1[0], v1[1]}), d = gelu_pk((f32x2){v1[2], v1[3]});
                        v0 = (f32x4){a.x, a.y, b.x, b.y}; v1 = (f32x4){c.x, c.y, d.x, d.y}; }
                    v0 = v0 * sc; v1 = v1 * sc; u32x4 w; w.x = cvt_pk_bf16(v0[0], v0[1]); w.y = cvt_pk_bf16(v0[2], v0[3]); w.z = cvt_pk_bf16(v1[0], v1[1]); w.w = cvt_pk_bf16(v1[2], v1[3]);
                    *(u32x4*)(rowp + bj * HALF) = w; } }
    }
};
struct EpiF32 {
    static constexpr bool PERM = false, AFTER_DRAIN = false;
    float* O; int ldc;
    __device__ __forceinline__ void operator()(const f32x4 (&acc)[2][2][4][2], const Unit& u, int wr, int wc, int fr, int fq) const {
        const int col0 = u.pn * BM + wc * 32 + 4 * fq;
#pragma unroll
        for (int ai = 0; ai < 2; ++ai)
#pragma unroll
            for (int m = 0; m < 4; ++m) { float* rowp = O + (size_t)(u.pm * BM + ai * HALF + wr * 64 + m * 16 + fr) * ldc + col0;
#pragma unroll
                for (int bj = 0; bj < 2; ++bj)
#pragma unroll
                    for (int n = 0; n < 2; ++n) *(f32x4*)(rowp + bj * HALF + n * 16) = acc[ai][bj][m][n]; }
    }
};
template <class Epi, class Sched, bool ALIGN_EPI = false, bool SP2 = false>
__device__ __forceinline__ void gemm_phase(PG8_LAS unsigned char* lds, const Gemm g, const Sched& S, const Epi& E) {
    const int tid = threadIdx.x, wid = __builtin_amdgcn_readfirstlane(tid >> 6), lane = tid & 63, wr = wid >> 2, wc = wid & 3, fr = lane & 15, fq = lane >> 4;
    const int K = g.K, nt = K / BK;
    unsigned voffA[2], voffB[2];
#pragma unroll
    for (int i = 0; i < 2; ++i) { int R, C; stage_rc(tid * 16 + i * 8192, R, C); const int Rb = Epi::PERM ? ((R & ~31) + perm32(R & 31)) : R;
        voffA[i] = (unsigned)(R * K + C) * 2u; voffB[i] = (unsigned)(Rb * K + C) * 2u; }
    const size_t kstep = (size_t)(BK * 2);
    const size_t hstep = (size_t)HALF * K * 2;
    const size_t tstep = 2 * hstep;
    const unsigned ldsw = (unsigned)wid * 1024u;
    const int aoff = lds_byte(wr * 64 + fr, fq * 8), boff = lds_byte(wc * 32 + fr, fq * 8);
#define PG8_SA(b, h) (((b) * 2 + (h)) * HTB)
#define PG8_SB(b, h) ((4 + (b) * 2 + (h)) * HTB)
#define PG8_STAGE(bufoff, gbase, voff) do { _Pragma("unroll") for (int _i = 0; _i < 2; ++_i) \
        __builtin_amdgcn_global_load_lds((const unsigned*)((const char*)(gbase) + (voff)[_i]), (PG8_LAS unsigned*)(lds + (bufoff) + ldsw + _i * 8192), 16, 0, 0); } while (0)
#define PG8_LDA(dst, b, h) do { _Pragma("unroll") for (int m = 0; m < 4; ++m) _Pragma("unroll") for (int k = 0; k < 2; ++k) dst[m][k] = *(const PG8_LAS bf16x8*)(lds + PG8_SA(b, h) + aoff + m * 2048 + k * 1024); } while (0)
#define PG8_LDB(dst, b, h) do { _Pragma("unroll") for (int n = 0; n < 2; ++n) _Pragma("unroll") for (int k = 0; k < 2; ++k) dst[n][k] = *(const PG8_LAS bf16x8*)(lds + PG8_SB(b, h) + boff + n * 2048 + k * 1024); } while (0)
#define PG8_MMA(ai, bj, At, Bt) do { __builtin_amdgcn_s_setprio(1); _Pragma("unroll") for (int m = 0; m < 4; ++m) _Pragma("unroll") for (int n = 0; n < 2; ++n) _Pragma("unroll") for (int k = 0; k < 2; ++k) \
        acc[ai][bj][m][n] = __builtin_amdgcn_mfma_f32_16x16x32_bf16(Bt[n][k], At[m][k], acc[ai][bj][m][n], 0, 0, 0); __builtin_amdgcn_s_setprio(0); } while (0)
#define PG8_WAIT_V(n) asm volatile("s_waitcnt vmcnt(" #n ")" ::: "memory")
#define PG8_WAIT_L(n) asm volatile("s_waitcnt lgkmcnt(" #n ")" ::: "memory")
#define PG8_BAR __builtin_amdgcn_s_barrier()
#define PG8_SCHED __builtin_amdgcn_sched_barrier(0)
    Unit cur, nxt; int ui = 0;
    if (!S.next(0, cur)) return;
    f32x4 acc[2][2][4][2];
#pragma unroll
    for (int a = 0; a < 2; ++a)
#pragma unroll
        for (int b = 0; b < 2; ++b)
#pragma unroll
            for (int m = 0; m < 4; ++m)
#pragma unroll
                for (int n = 0; n < 2; ++n) acc[a][b][m][n] = (f32x4){0.f, 0.f, 0.f, 0.f};
    bf16x8 At[4][2], B0[2][2], B1[2][2];
    const char* cA = (const char*)g.A + (size_t)cur.pm * tstep; const char* cB = (const char*)g.Bt + (size_t)cur.pn * tstep;
    S.a_ready(cur);
    if constexpr (SP2) {
        PG8_STAGE(PG8_SB(0, 0), cB, voffB); PG8_STAGE(PG8_SB(0, 1), cB + hstep, voffB); PG8_STAGE(PG8_SA(0, 0), cA, voffA); PG8_STAGE(PG8_SA(0, 1), cA + hstep, voffA);
        if (wr == 1) PG8_BAR;
        PG8_WAIT_V(2); PG8_BAR;
        PG8_STAGE(PG8_SB(1, 0), cB + kstep, voffB); PG8_STAGE(PG8_SA(1, 0), cA + kstep, voffA); PG8_STAGE(PG8_SB(1, 1), cB + hstep + kstep, voffB);
        PG8_WAIT_V(6); PG8_BAR;
    } else {
        PG8_STAGE(PG8_SB(0, 0), cB, voffB); PG8_STAGE(PG8_SA(0, 0), cA, voffA); PG8_STAGE(PG8_SB(0, 1), cB + hstep, voffB); PG8_STAGE(PG8_SA(0, 1), cA + hstep, voffA);
        if (wr == 1) PG8_BAR;
        PG8_WAIT_V(4); PG8_BAR;
        PG8_STAGE(PG8_SB(1, 0), cB + kstep, voffB); PG8_STAGE(PG8_SA(1, 0), cA + kstep, voffA); PG8_STAGE(PG8_SB(1, 1), cB + hstep + kstep, voffB);
        PG8_WAIT_V(6); PG8_BAR;
    }
    for (;;) {
        const bool has_next = S.next(ui + 1, nxt);
        const char* nA = has_next ? (const char*)g.A + (size_t)nxt.pm * tstep : cA; const char* nB = has_next ? (const char*)g.Bt + (size_t)nxt.pn * tstep : cB;
        for (int t = 0; t < nt; t += 2) {
            const bool last = (t == nt - 2);
            const char* a1 = cA + (size_t)(t + 1) * kstep;
            const char* a2 = last ? nA : cA + (size_t)(t + 2) * kstep; const char* b2 = last ? nB : cB + (size_t)(t + 2) * kstep;
            const char* a3 = a2 + kstep; const char* b3 = b2 + kstep;
            if (last && has_next) S.a_ready(nxt);
            if constexpr (SP2) {
            PG8_LDB(B0, 0, 0); PG8_LDB(B1, 0, 1); PG8_SCHED; PG8_LDA(At, 0, 0); PG8_STAGE(PG8_SA(1, 1), a1 + hstep, voffA);
            PG8_WAIT_V(8); PG8_WAIT_L(0); PG8_BAR; PG8_MMA(0, 0, At, B0); PG8_MMA(0, 1, At, B1); PG8_BAR; PG8_SCHED;
            PG8_LDA(At, 0, 1); PG8_STAGE(PG8_SB(0, 0), b2, voffB); PG8_STAGE(PG8_SB(0, 1), b2 + hstep, voffB); PG8_STAGE(PG8_SA(0, 0), a2, voffA);
            PG8_WAIT_V(8); PG8_WAIT_L(0); PG8_BAR; PG8_MMA(1, 0, At, B0); PG8_MMA(1, 1, At, B1); PG8_BAR; PG8_SCHED;
            PG8_LDB(B0, 1, 0); PG8_LDB(B1, 1, 1); PG8_SCHED; PG8_LDA(At, 1, 0); PG8_STAGE(PG8_SA(0, 1), a2 + hstep, voffA);
            PG8_WAIT_V(8); PG8_WAIT_L(0); PG8_BAR; PG8_MMA(0, 0, At, B0); PG8_MMA(0, 1, At, B1); PG8_BAR; PG8_SCHED;
            PG8_LDA(At, 1, 1); PG8_STAGE(PG8_SB(1, 0), b3, voffB); PG8_STAGE(PG8_SB(1, 1), b3 + hstep, voffB); PG8_STAGE(PG8_SA(1, 0), a3, voffA);
            PG8_WAIT_V(8); PG8_WAIT_L(0); PG8_BAR; PG8_MMA(1, 0, At, B0); PG8_MMA(1, 1, At, B1); PG8_BAR; PG8_SCHED;
            } else {
            PG8_LDB(B0, 0, 0); PG8_SCHED; PG8_LDA(At, 0, 0); PG8_STAGE(PG8_SA(1, 1), a1 + hstep, voffA);
            PG8_WAIT_L(8); PG8_BAR; PG8_WAIT_L(0); PG8_MMA(0, 0, At, B0); PG8_BAR; PG8_SCHED;
            PG8_LDB(B1, 0, 1); PG8_STAGE(PG8_SB(0, 0), b2, voffB);
            PG8_BAR; PG8_WAIT_L(0); PG8_MMA(0, 1, At, B1); PG8_BAR;
            PG8_LDA(At, 0, 1); PG8_STAGE(PG8_SA(0, 0), a2, voffA);
            PG8_BAR; PG8_WAIT_L(0); PG8_MMA(1, 0, At, B0); PG8_BAR; PG8_SCHED;
            PG8_STAGE(PG8_SB(0, 1), b2 + hstep, voffB);
            PG8_WAIT_V(6); PG8_BAR; PG8_MMA(1, 1, At, B1); PG8_BAR;
            PG8_LDB(B0, 1, 0); PG8_SCHED; PG8_LDA(At, 1, 0); PG8_STAGE(PG8_SA(0, 1), a2 + hstep, voffA);
            PG8_WAIT_L(8); PG8_BAR; PG8_WAIT_L(0); PG8_MMA(0, 0, At, B0); PG8_BAR; PG8_SCHED;
            PG8_LDB(B1, 1, 1); PG8_STAGE(PG8_SB(1, 0), b3, voffB);
            PG8_BAR; PG8_WAIT_L(0); PG8_MMA(0, 1, At, B1); PG8_BAR;
            PG8_LDA(At, 1, 1); PG8_STAGE(PG8_SA(1, 0), a3, voffA);
            PG8_BAR; PG8_WAIT_L(0); PG8_MMA(1, 0, At, B0); PG8_BAR; PG8_SCHED;
            PG8_STAGE(PG8_SB(1, 1), b3 + hstep, voffB);
            PG8_WAIT_V(6); PG8_BAR; PG8_MMA(1, 1, At, B1); PG8_BAR;
            }
        }
        if constexpr (ALIGN_EPI) { if (wr == 0) PG8_BAR; }
        if constexpr (!Epi::AFTER_DRAIN) { E(acc, cur, wr, wc, fr, fq); S.done(cur); }
        if (!has_next) break;
#pragma unroll
        for (int a = 0; a < 2; ++a)
#pragma unroll
            for (int b = 0; b < 2; ++b)
#pragma unroll
                for (int m = 0; m < 4; ++m)
#pragma unroll
                    for (int n = 0; n < 2; ++n) acc[a][b][m][n] = (f32x4){0.f, 0.f, 0.f, 0.f};
        cur = nxt; cA = nA; cB = nB; ++ui;
        if constexpr (ALIGN_EPI) { if (wr == 1) PG8_BAR; }
    }
    PG8_WAIT_V(0);
    if constexpr (!ALIGN_EPI) { if (wr == 0) PG8_BAR; }
    PG8_BAR;
    if constexpr (Epi::AFTER_DRAIN) { E.fused(acc, cur, wr, wc, fr, fq, lds, wid, lane); S.done(cur); }
#undef PG8_SA
#undef PG8_SB
#undef PG8_STAGE
#undef PG8_LDA
#undef PG8_LDB
#undef PG8_MMA
#undef PG8_WAIT_V
#undef PG8_WAIT_L
#undef PG8_BAR
#undef PG8_SCHED
}
}
#define GAS __attribute__((address_space(1)))
#define LAS __attribute__((address_space(3)))
typedef unsigned short bf16;
typedef unsigned v4u __attribute__((ext_vector_type(4)));
typedef unsigned v2u __attribute__((ext_vector_type(2)));
typedef float f32x4 __attribute__((ext_vector_type(4)));
typedef float f32x2 __attribute__((ext_vector_type(2)));
typedef short bf16x8 __attribute__((ext_vector_type(8)));
typedef short s16x4 __attribute__((ext_vector_type(4)));

constexpr int NB = 8, T = 2048, D = 2048, M = NB * T;
constexpr int NIN = 6784, NP = 6912;
constexpr int C_Q = 0, C_K = 1024, C_V = 1280, C_GA = 1536, C_R = 2560, C_RK = 3584, C_RV = 4608, C_WD = 5632, C_AD = 5696, C_GR = 5760;
constexpr size_t MiB = 1u << 20;
constexpr size_t WS_MOD = 0;
constexpr size_t WS_CTL = 512 * 1024, CTL_BYTES = 16384;
constexpr size_t WS_WIN = 2 * MiB;
constexpr size_t WS_WOUT = 29 * MiB;
constexpr size_t WS_H = 40 * MiB;
constexpr size_t WS_PROJ = 104 * MiB;
constexpr size_t WS_MIXOUT = 320 * MiB;
constexpr size_t WS_XW = 2 * MiB;
constexpr size_t WS_XA = 4 * MiB;
constexpr size_t WS_RN = 6 * MiB;
constexpr size_t WS_IMGA = 7 * MiB;
constexpr size_t WS_IMGB = 320 * MiB;
constexpr size_t WS_END = 500 * MiB;
constexpr int LDS_BYTES = 147456, RING_BYTES = 131072;
constexpr int NWAVES = 8;

__device__ __forceinline__ float rcp_f(float v) { return __builtin_amdgcn_rcpf(v); }
#define LDS_WAIT() asm volatile("s_waitcnt lgkmcnt(0)" ::: "memory")
__device__ __forceinline__ unsigned f2bf(float f) { unsigned u = __builtin_bit_cast(unsigned, f); return (u + 0x7fffu + ((u >> 16) & 1u)) >> 16; }
typedef __bf16 bf16x2_t __attribute__((ext_vector_type(2)));
__device__ __forceinline__ unsigned pk2(float lo, float hi) { const f32x2 v = {lo, hi}; return __builtin_bit_cast(unsigned, __builtin_convertvector(v, bf16x2_t)); }
__device__ __forceinline__ float tanh_f(float v) { return 1.f - 2.f * rcp_f(__expf(2.f * v) + 1.f); }
__device__ __forceinline__ float bflo(unsigned u) { return __builtin_bit_cast(float, u << 16); }
__device__ __forceinline__ float bfhi(unsigned u) { return __builtin_bit_cast(float, u & 0xffff0000u); }
__device__ __forceinline__ float silu_f(float v) { return v * rcp_f(1.f + __expf(-v)); }
__device__ __forceinline__ float wave_sum(float v) {
#pragma unroll
    for (int o = 1; o < 64; o <<= 1) v += __shfl_xor(v, o);
    return v;
}
template <int CTRL> __device__ __forceinline__ float dpp_add(float x) {
    const int y = __builtin_amdgcn_update_dpp(0, __builtin_bit_cast(int, x), CTRL, 0xF, 0xF, false);
    return x + __builtin_bit_cast(float, y);
}
__device__ __forceinline__ float reduce16(float x) {
    x = dpp_add<0x128>(x); x = dpp_add<0x124>(x); x = dpp_add<0x122>(x); x = dpp_add<0x121>(x);
    return x;
}
__device__ __forceinline__ float half_sum(float v) {
    v = reduce16(v); v += __shfl_xor(v, 16);
    return v;
}
struct Args { const float* in[19]; float* out; unsigned char* ws; };

__device__ __forceinline__ void p0_transpose_item(const float* W, int K, int N, bf16* WT, LAS float* scr, int item, int lane) {
    const int nblk = N / 32, kb = item / nblk, nb = item % nblk, k0 = 64 * kb, n0 = 32 * nb;
    float wv[32];
#pragma unroll
    for (int i = 0; i < 32; ++i) wv[i] = W[(size_t)(k0 + 2 * i + (lane >> 5)) * N + n0 + (lane & 31)];
#pragma unroll
    for (int i = 0; i < 32; ++i) scr[(2 * i + (lane >> 5)) * 33 + (lane & 31)] = wv[i];
    LDS_WAIT(); asm volatile("" ::: "memory");
    const int c = lane & 7;
#pragma unroll
    for (int j = 0; j < 4; ++j) { const int n = (lane >> 3) + 8 * j; const LAS float* s = scr + (8 * c) * 33 + n;
        v4u o; o.x = pk2(s[0 * 33], s[1 * 33]); o.y = pk2(s[2 * 33], s[3 * 33]); o.z = pk2(s[4 * 33], s[5 * 33]); o.w = pk2(s[6 * 33], s[7 * 33]);
        *(v4u*)(WT + (size_t)(n0 + n) * K + k0 + 8 * c) = o; }
    LDS_WAIT(); asm volatile("" ::: "memory");
}

__device__ __forceinline__ void phase0(LAS unsigned char* lds, const Args& a, int tid, int wave, int lane) {
    const float* c = a.in[1]; const float* w_ada = a.in[2]; const float* b_ada = a.in[3];
    float* mod = (float*)(a.ws + WS_MOD);
    if (blockIdx.x < 192) {
        LAS float* s = (LAS float*)lds;
        LAS float* red = s + 16384;
        for (int i = tid; i < 8 * 2048; i += 512) s[i] = silu_f(c[i]);
        __syncthreads();
        const int j = blockIdx.x, cgp = tid & 7, kp = tid >> 3;
        float acc[8][4];
#pragma unroll
        for (int b = 0; b < 8; ++b)
#pragma unroll
            for (int e = 0; e < 4; ++e) acc[b][e] = 0.f;
#pragma unroll 8
        for (int i = 0; i < 32; ++i) {
            const int k = kp + 64 * i;
            const f32x4 wv = *(const f32x4*)(w_ada + (size_t)k * 6144 + 32 * j + 4 * cgp);
#pragma unroll
            for (int b = 0; b < 8; ++b) { const float sv = s[b * 2048 + k];
#pragma unroll
                for (int e = 0; e < 4; ++e) acc[b][e] += sv * wv[e]; }
        }
#pragma unroll
        for (int b = 0; b < 8; ++b)
#pragma unroll
            for (int e = 0; e < 4; ++e) red[kp * 256 + b * 32 + 4 * cgp + e] = acc[b][e];
        __syncthreads();
        if (tid < 256) {
            float sum = 0.f;
            for (int q = 0; q < 64; ++q) sum += red[q * 256 + tid];
            const int b = tid >> 5, col = tid & 31;
            mod[b * 6144 + 32 * j + col] = sum + b_ada[32 * j + col];
        }
        __syncthreads();
    }
    LAS float* scr = (LAS float*)(lds + wave * 16384);
    const int gw = blockIdx.x * NWAVES + wave, NGW = gridDim.x * NWAVES;
    bf16* WinT = (bf16*)(a.ws + WS_WIN); bf16* WoutT = (bf16*)(a.ws + WS_WOUT);
    constexpr int I_IN = (D / 64) * (NIN / 32), I_OUT = (D / 64) * (D / 32);
    for (int it = gw; it < I_IN + I_OUT; it += NGW) {
        if (it < I_IN) p0_transpose_item(a.in[6], D, NIN, WinT, scr, it, lane);
        else p0_transpose_item(a.in[7], D, D, WoutT, scr, it - I_IN, lane);
    }
    { v4u* z = (v4u*)(WinT + (size_t)NIN * D); const int nz = (NP - NIN) * D * 2 / 16;
      for (int i = blockIdx.x * 512 + tid; i < nz; i += gridDim.x * 512) z[i] = (v4u){0u, 0u, 0u, 0u}; }
}

__device__ __forceinline__ void phase1(const Args& a, int wave, int lane) {
    const float* x = a.in[0]; const float* g = a.in[4];
    const float* mod = (const float*)(a.ws + WS_MOD); bf16* H = (bf16*)(a.ws + WS_H);
    const int gw = blockIdx.x * NWAVES + wave, NGW = gridDim.x * NWAVES;
    for (int m = gw; m < M; m += NGW) {
        const int b = m >> 11;
        const f32x4* xr = (const f32x4*)(x + (size_t)m * D) + lane;
        f32x4 v[8]; float ss = 0.f;
#pragma unroll
        for (int j = 0; j < 8; ++j) { v[j] = xr[64 * j]; ss += (v[j].x * v[j].x + v[j].y * v[j].y) + (v[j].z * v[j].z + v[j].w * v[j].w); }
        const float rinv = rsqrtf(wave_sum(ss) * (1.f / D) + 1e-6f);
        v2u* o8 = (v2u*)(H + (size_t)m * D) + lane;
#pragma unroll
        for (int j = 0; j < 8; ++j) {
            const int col = 4 * lane + 256 * j;
            const f32x4 g4 = *(const f32x4*)(g + col);
            const f32x4 sh = *(const f32x4*)(mod + b * 6144 + col);
            const f32x4 sc = *(const f32x4*)(mod + b * 6144 + 2048 + col);
            const f32x4 o = v[j] * rinv * g4 * (sc + 1.f) + sh;
            v2u w; w.x = pk2(o.x, o.y); w.y = pk2(o.z, o.w);
            o8[64 * j] = w;
        }
    }
}

__device__ __forceinline__ void attn_phase(LAS unsigned char* lds, const bf16* P, bf16* mix, const float* sinks, int u0, int ustride, int nunits, int tid, int wave, int lane) {
    constexpr int KP = 72, VP = 264;
    LAS bf16* Ks = (LAS bf16*)lds;
    LAS bf16* Vt = (LAS bf16*)(lds + 36864);
    const int c = lane & 15, hq = lane >> 4, g = wave >> 1, half = wave & 1;
    v4u kv[4], vv[4];
#define A_LOAD(uu) do { const int b_ = (uu) >> 6, n_ = ((uu) >> 2) & 15, hk_ = (uu) & 3; \
        _Pragma("unroll") for (int i = 0; i < 4; ++i) { const int idx = tid + 512 * i, key = idx >> 3, part = idx & 7, tok = (n_ - 1) * 128 + key; \
            kv[i] = (v4u){0u, 0u, 0u, 0u}; vv[i] = (v4u){0u, 0u, 0u, 0u}; \
            if (tok >= 0) { const size_t row = (size_t)(b_ * T + tok) * NP; kv[i] = *(const v4u*)(P + row + C_K + hk_ * 64 + part * 8); vv[i] = *(const v4u*)(P + row + C_V + hk_ * 64 + part * 8); } } } while (0)
    A_LOAD(u0);
    for (int ui = 0; ui < nunits; ++ui) {
        const int u = u0 + ui * ustride, b = u >> 6, n = (u >> 2) & 15, hk = u & 3, head = hk * 4 + g;
#pragma unroll
        for (int i = 0; i < 4; ++i) { const int idx = tid + 512 * i, key = idx >> 3, part = idx & 7;
            *(LAS v4u*)(Ks + key * KP + part * 8) = kv[i];
#pragma unroll
            for (int e = 0; e < 8; ++e) Vt[(part * 8 + e) * VP + key] = (bf16)((vv[i][e >> 1] >> (16 * (e & 1))) & 0xffffu); }
        __syncthreads();
        if (ui + 1 < nunits) A_LOAD(u + ustride);
        const float sink = sinks[head];
        const size_t rowq = (size_t)(b * T + n * 128 + half * 64 + c);
        bf16x8 qf[2], nqf[2]; v2u ga[4], nga[4];
#pragma unroll
        for (int ks = 0; ks < 2; ++ks) qf[ks] = *(const bf16x8*)(P + rowq * NP + C_Q + head * 64 + 32 * ks + 8 * hq);
#pragma unroll
        for (int dt = 0; dt < 4; ++dt) ga[dt] = *(const v2u*)(P + rowq * NP + C_GA + head * 64 + 16 * dt + 4 * hq);
        for (int ch = 0; ch < 4; ++ch) {
            const int q0 = half * 64 + ch * 16, tb = ((q0 >> 4) >> 1) * 2;
            if (ch + 1 < 4) { const size_t rn = (rowq + 16 * (ch + 1)) * NP;
#pragma unroll
                for (int ks = 0; ks < 2; ++ks) nqf[ks] = *(const bf16x8*)(P + rn + C_Q + head * 64 + 32 * ks + 8 * hq);
#pragma unroll
                for (int dt = 0; dt < 4; ++dt) nga[dt] = *(const v2u*)(P + rn + C_GA + head * 64 + 16 * dt + 4 * hq); }
            f32x4 s[10];
#pragma unroll
            for (int tl = 0; tl < 10; ++tl) {
                f32x4 acc = (f32x4){0.f, 0.f, 0.f, 0.f};
#pragma unroll
                for (int ks = 0; ks < 2; ++ks) { const bf16x8 kf = *(const LAS bf16x8*)(Ks + (16 * (tb + tl) + c) * KP + 32 * ks + 8 * hq);
                    acc = __builtin_amdgcn_mfma_f32_16x16x32_bf16(kf, qf[ks], acc, 0, 0, 0); }
                s[tl] = acc;
            }
            const int qi = q0 + c;
            float mx = sink;
#pragma unroll
            for (int tl = 0; tl < 10; ++tl)
#pragma unroll
                for (int r = 0; r < 4; ++r) { const int si = 16 * (tb + tl) + 4 * hq + r;
                    const bool valid = (si > qi) && (si <= qi + 128) && (n > 0 || si >= 128);
                    const float sv = valid ? s[tl][r] * 0.125f : -1e30f; s[tl][r] = sv; mx = fmaxf(mx, sv); }
            mx = fmaxf(mx, __shfl_xor(mx, 16)); mx = fmaxf(mx, __shfl_xor(mx, 32));
            float sum = 0.f;
#pragma unroll
            for (int tl = 0; tl < 10; ++tl)
#pragma unroll
                for (int r = 0; r < 4; ++r) { const float p = __expf(s[tl][r] - mx); s[tl][r] = p; sum += p; }
            sum += __shfl_xor(sum, 16); sum += __shfl_xor(sum, 32);
            const float inv = rcp_f(sum + __expf(sink - mx));
            f32x4 o[4];
#pragma unroll
            for (int dt = 0; dt < 4; ++dt) o[dt] = (f32x4){0.f, 0.f, 0.f, 0.f};
#pragma unroll
            for (int kp = 0; kp < 5; ++kp) {
                v4u pw; pw.x = pk2(s[2 * kp][0], s[2 * kp][1]); pw.y = pk2(s[2 * kp][2], s[2 * kp][3]); pw.z = pk2(s[2 * kp + 1][0], s[2 * kp + 1][1]); pw.w = pk2(s[2 * kp + 1][2], s[2 * kp + 1][3]);
                const bf16x8 pf = __builtin_bit_cast(bf16x8, pw);
#pragma unroll
                for (int dt = 0; dt < 4; ++dt) {
                    const v2u v0 = *(const LAS v2u*)(Vt + (16 * dt + c) * VP + 16 * (tb + 2 * kp) + 4 * hq);
                    const v2u v1 = *(const LAS v2u*)(Vt + (16 * dt + c) * VP + 16 * (tb + 2 * kp + 1) + 4 * hq);
                    v4u vw; vw.x = v0.x; vw.y = v0.y; vw.z = v1.x; vw.w = v1.y;
                    o[dt] = __builtin_amdgcn_mfma_f32_16x16x32_bf16(__builtin_bit_cast(bf16x8, vw), pf, o[dt], 0, 0, 0);
                }
            }
            bf16* orow = mix + (rowq + 16 * ch) * D + head * 64 + 4 * hq;
#pragma unroll
            for (int dt = 0; dt < 4; ++dt) {
                const float g0 = bflo(ga[dt].x), g1 = bfhi(ga[dt].x), g2 = bflo(ga[dt].y), g3 = bfhi(ga[dt].y);
                v2u w; w.x = pk2(o[dt][0] * inv * silu_f(g0), o[dt][1] * inv * silu_f(g1)); w.y = pk2(o[dt][2] * inv * silu_f(g2), o[dt][3] * inv * silu_f(g3));
                *(v2u*)(orow + 16 * dt) = w;
            }
#pragma unroll
            for (int ks = 0; ks < 2; ++ks) qf[ks] = nqf[ks];
#pragma unroll
            for (int dt = 0; dt < 4; ++dt) ga[dt] = nga[dt];
        }
        __syncthreads();
    }
#undef A_LOAD
}

#define XB_TMO      128
#define XB_XCNT(j)  (256  + 64 * (j))
#define XB_XSUB(j)  (1280 + 64 * (j))
#define XB_XGEN(j)  (2304 + 64 * (j))
#define XB_TOP      3328
#define XB_TOPGEN   3392
#define XCD_BAR_WORDS 3456
#define XB_SPIN_CAP (1u << 18)

__device__ __forceinline__ unsigned xb_ld(unsigned* p)              { return __hip_atomic_load(p, __ATOMIC_RELAXED, __HIP_MEMORY_SCOPE_AGENT); }
__device__ __forceinline__ unsigned xb_add(unsigned* p, unsigned v) { return __hip_atomic_fetch_add(p, v, __ATOMIC_RELAXED, __HIP_MEMORY_SCOPE_AGENT); }
__device__ __forceinline__ unsigned xb_xcc_id() { return (unsigned)__builtin_amdgcn_s_getreg((3 << 11) | 20) & 0xFu; }
#define XB_SPIN(cond, bar) do { unsigned _sp = 0; while (cond) { __builtin_amdgcn_s_sleep(1); \
    if ((++_sp & 255u) == 0u) { if (xb_ld(&(bar)[XB_TMO])) break; if (_sp > XB_SPIN_CAP) { atomicAdd(&(bar)[XB_TMO], 1u); break; } } } } while (0)

struct XcdBarrier {
    unsigned* bar; unsigned x;
    volatile LAS unsigned* st;
};

__device__ __forceinline__ XcdBarrier xcd_barrier_post(unsigned* bar, volatile LAS unsigned* st) {
    XcdBarrier b; b.bar = bar; b.x = xb_xcc_id(); b.st = st;
    if (threadIdx.x == 0) (void)xb_add(&bar[XB_XCNT(b.x)], 1u);
    return b;
}
__device__ __forceinline__ void xcd_barrier_complete(unsigned* bar, unsigned x, unsigned& nloc, unsigned& nx) {
    const unsigned G = gridDim.x * gridDim.y * gridDim.z;
    unsigned sum, cnt, mine, sp = 0u;
    for (;;) {
        sum = 0u; cnt = 0u; mine = 0u;
#pragma unroll
        for (unsigned j = 0; j < 16; ++j) { const unsigned c = xb_ld(&bar[XB_XCNT(j)]); sum += c; cnt += (c > 0u) ? 1u : 0u; mine = (j == x) ? c : mine; }
        if (sum == G) break;
        __builtin_amdgcn_s_sleep(1);
        if ((++sp & 255u) == 0u) { if (xb_ld(&bar[XB_TMO])) break; if (sp > XB_SPIN_CAP) { atomicAdd(&bar[XB_TMO], 1u); break; } }
    }
    nloc = mine > 0u ? mine : 1u; nx = cnt > 0u ? cnt : 1u;
}

__device__ __forceinline__ void xcd_barrier(const XcdBarrier& b) {
    asm volatile("s_waitcnt vmcnt(0)" ::: "memory");
    __syncthreads();
    if (threadIdx.x == 0) {
        unsigned* bar = b.bar;
        __builtin_amdgcn_s_waitcnt(0);
        unsigned nloc = b.st[0], nx = b.st[1];
        if (nloc == 0u) { xcd_barrier_complete(bar, b.x, nloc, nx); b.st[0] = nloc; b.st[1] = nx; }
        const unsigned old = xb_add(&bar[XB_XSUB(b.x)], 1u);
        const unsigned gen = old / nloc;
        if (old + 1u == (gen + 1u) * nloc) {
            __builtin_amdgcn_fence(__ATOMIC_RELEASE, "agent");
            asm volatile("s_waitcnt vmcnt(0)" ::: "memory");
            const unsigned og = xb_add(&bar[XB_TOP], 1u);
            const unsigned tg = og / nx;
            if (og + 1u == (tg + 1u) * nx) xb_add(&bar[XB_TOPGEN], 1u);
            else XB_SPIN(xb_ld(&bar[XB_TOPGEN]) == tg, bar);
            __builtin_amdgcn_fence(__ATOMIC_ACQUIRE, "agent");
            xb_add(&bar[XB_XGEN(b.x)], 1u);
            asm volatile("s_waitcnt vmcnt(0)" ::: "memory");
        } else {
            XB_SPIN(xb_ld(&bar[XB_XGEN(b.x)]) == gen, bar);
            __builtin_amdgcn_fence(__ATOMIC_ACQUIRE, "agent");
            asm volatile("s_waitcnt vmcnt(0)" ::: "memory");
        }
    }
    __syncthreads();
}
__device__ __forceinline__ void phase25(const Args& a, int wave, int lane) {
    const bf16* P = (const bf16*)(a.ws + WS_PROJ);
    bf16* XW = (bf16*)(a.ws + WS_XW); bf16* XA = (bf16*)(a.ws + WS_XA); float* RN = (float*)(a.ws + WS_RN);
    const float* mu = a.in[9]; const float* k_k = a.in[14];
    const float mu_w = mu[3072 + lane], mu_a = mu[3136 + lane];
    float muk[16], kkc[16];
#pragma unroll
    for (int j = 0; j < 16; ++j) { muk[j] = mu[1024 + lane * 16 + j]; kkc[j] = k_k[lane * 16 + j]; }
    const int gw = blockIdx.x * NWAVES + wave, NGW = gridDim.x * NWAVES;
    for (int m = gw; m < M; m += NGW) {
        const bool first = (m & (T - 1)) == 0;
        const bf16* pr = P + (size_t)m * NP;
        const float wc = bflo((unsigned)pr[C_WD + lane]), ac = bflo((unsigned)pr[C_AD + lane]);
        const float wp = first ? 0.f : bflo((unsigned)pr[C_WD + lane - NP]), ap = first ? 0.f : bflo((unsigned)pr[C_AD + lane - NP]);
        XW[(size_t)m * 64 + lane] = (bf16)f2bf(tanh_f(wc + (wp - wc) * mu_w));
        XA[(size_t)m * 64 + lane] = (bf16)f2bf(ac + (ap - ac) * mu_a);
        v4u kc[2], kp[2];
#pragma unroll
        for (int h = 0; h < 2; ++h) { kc[h] = *(const v4u*)(pr + C_RK + lane * 16 + 8 * h);
            kp[h] = first ? (v4u){0u, 0u, 0u, 0u} : *(const v4u*)(pr - NP + C_RK + lane * 16 + 8 * h); }
        float ssq = 0.f;
#pragma unroll
        for (int h = 0; h < 2; ++h)
#pragma unroll
            for (int j = 0; j < 4; ++j) {
                const float c0 = bflo(kc[h][j]), c1 = bfhi(kc[h][j]), p0 = bflo(kp[h][j]), p1 = bfhi(kp[h][j]);
                const float k0 = (c0 + (p0 - c0) * muk[8 * h + 2 * j]) * kkc[8 * h + 2 * j], k1 = (c1 + (p1 - c1) * muk[8 * h + 2 * j + 1]) * kkc[8 * h + 2 * j + 1];
                ssq += k0 * k0 + k1 * k1; }
        ssq = dpp_add<0xB1>(ssq); ssq = dpp_add<0x4E>(ssq);
        if ((lane & 3) == 0) RN[(size_t)m * 16 + (lane >> 2)] = rsqrtf(fmaxf(ssq, 1e-24f));
    }
}

constexpr int TC = 16, NCH = T / TC;
constexpr int IMG = 12864, I_PA = 0, I_A2 = 4096, I_V = 8192, I_DE = 12288, I_SC = 12544, I_BON = 12800;
constexpr int STG = 14144, P_SC = 12864, P_BON = 13888;
#define WG_BAR() do { asm volatile("s_waitcnt lgkmcnt(0)" ::: "memory"); __builtin_amdgcn_s_barrier(); asm volatile("" ::: "memory"); } while (0)
__device__ __forceinline__ unsigned char* img_ptr(unsigned char* ws, int chain, int chunk) {
    return chain < 14 ? ws + WS_IMGA + ((size_t)chain * NCH + chunk) * IMG : ws + WS_IMGB + ((size_t)(chain - 14) * NCH + chunk) * IMG;
}

__device__ __forceinline__ void rwkv_prepass(LAS unsigned char* lds, const Args& a, int tid, int wave, int lane, int cb, int nch, int G, int bidx) {
    const bf16* P = (const bf16*)(a.ws + WS_PROJ);
    const bf16* XW = (const bf16*)(a.ws + WS_XW); const bf16* XA = (const bf16*)(a.ws + WS_XA); const float* RN = (const float*)(a.ws + WS_RN);
    const int g = wave >> 2, hw = wave & 3, grp = bidx * 2 + g, gpc = G >> 6, ntask = nch / gpc, chain = grp / gpc, c0 = cb + (grp % gpc) * ntask;
    const int b = chain >> 4; const unsigned hh = chain & 15, rowbase = (unsigned)b * T;
    const unsigned cc = lane & 15, hq = lane >> 4; const int ch = 16 * hw + (int)cc; const unsigned col = hh * 64 + ch; const int tg = tid & 255;
    const float* mu = a.in[9];
    const float cw0 = a.in[10][col], ca0 = a.in[12][col], ckk = a.in[14][col], cka = a.in[15][col], crk = a.in[16][col];
    const float mur = mu[col], muk = mu[1024 + col], muv = mu[2048 + col];
    bf16x8 bwf[2], baf[2];
#pragma unroll
    for (int ks = 0; ks < 2; ++ks) {
        float tw[8], ta[8];
#pragma unroll
        for (int j = 0; j < 8; ++j) { const size_t o = (size_t)(32 * ks + 8 * hq + j) * 1024 + col; tw[j] = a.in[11][o]; ta[j] = a.in[13][o]; }
        v4u w; w.x = pk2(tw[0], tw[1]); w.y = pk2(tw[2], tw[3]); w.z = pk2(tw[4], tw[5]); w.w = pk2(tw[6], tw[7]); bwf[ks] = __builtin_bit_cast(bf16x8, w);
        v4u v; v.x = pk2(ta[0], ta[1]); v.y = pk2(ta[2], ta[3]); v.z = pk2(ta[4], ta[5]); v.w = pk2(ta[6], ta[7]); baf[ks] = __builtin_bit_cast(bf16x8, v);
    }
    const int pa_w = (hw >> 1) * 256 + (cc >> 2) * 16 + ((hw & 1) * 4 + (cc & 3)) * 2;
    v4u n_aw[2], n_aa[2], c_aw[2], c_aa[2], m_aw[2], m_aa[2];
    unsigned n_rc[4], n_kc[4], n_vc[4], n_rp, n_kp, n_vp, c_rc[4], c_kc[4], c_vc[4], c_rp, c_kp, c_vp, m_rc[4], m_kc[4], m_vc[4], m_rp, m_kp, m_vp;
    float n_rn[4], c_rn[4], m_rn[4];
#define H_LOAD(k) do { const unsigned t0_ = (unsigned)(k) * TC; const unsigned ra_ = (rowbase + t0_ + cc) * 64u + 8u * hq; \
        _Pragma("unroll") for (int ks = 0; ks < 2; ++ks) { n_aw[ks] = *(const v4u*)(XW + (ra_ + 32u * ks)); n_aa[ks] = *(const v4u*)(XA + (ra_ + 32u * ks)); } \
        const unsigned tb_ = t0_ + 4u * hq, pe_ = (rowbase + tb_) * (unsigned)NP + col; \
        _Pragma("unroll") for (int r = 0; r < 4; ++r) { n_rc[r] = P[pe_ + (unsigned)(r * NP + C_R)]; n_kc[r] = P[pe_ + (unsigned)(r * NP + C_RK)]; n_vc[r] = P[pe_ + (unsigned)(r * NP + C_RV)]; \
            n_rn[r] = RN[(rowbase + tb_ + r) * 16u + hh]; } \
        if (tb_ > 0u) { n_rp = P[pe_ - (unsigned)(NP - C_R)]; n_kp = P[pe_ - (unsigned)(NP - C_RK)]; n_vp = P[pe_ - (unsigned)(NP - C_RV)]; } else { n_rp = 0u; n_kp = 0u; n_vp = 0u; } \
    } while (0)
#define H_ADV() do { _Pragma("unroll") for (int ks = 0; ks < 2; ++ks) { c_aw[ks] = m_aw[ks]; c_aa[ks] = m_aa[ks]; m_aw[ks] = n_aw[ks]; m_aa[ks] = n_aa[ks]; } \
        _Pragma("unroll") for (int r = 0; r < 4; ++r) { c_rc[r] = m_rc[r]; c_kc[r] = m_kc[r]; c_vc[r] = m_vc[r]; c_rn[r] = m_rn[r]; m_rc[r] = n_rc[r]; m_kc[r] = n_kc[r]; m_vc[r] = n_vc[r]; m_rn[r] = n_rn[r]; } \
        c_rp = m_rp; c_kp = m_kp; c_vp = m_vp; m_rp = n_rp; m_kp = n_kp; m_vp = n_vp; } while (0)
    H_LOAD(c0); H_ADV(); H_LOAD(c0 + 1);
    for (int k = 0; k < ntask; ++k) {
        LAS unsigned char* B_ = lds + (g * 2 + (k & 1)) * STG;
        H_ADV();
        if (k + 2 < ntask) H_LOAD(c0 + k + 2);
        f32x4 accw = (f32x4){0.f, 0.f, 0.f, 0.f}, acca = (f32x4){0.f, 0.f, 0.f, 0.f};
#pragma unroll
        for (int ks = 0; ks < 2; ++ks) { accw = __builtin_amdgcn_mfma_f32_16x16x32_bf16(__builtin_bit_cast(bf16x8, c_aw[ks]), bwf[ks], accw, 0, 0, 0);
            acca = __builtin_amdgcn_mfma_f32_16x16x32_bf16(__builtin_bit_cast(bf16x8, c_aa[ks]), baf[ks], acca, 0, 0, 0); }
        float dec_[4], rr_[4], vx_[4], kkn_[4], k2_[4], bv_[4], pbo_[4], psc_[2][8];
#pragma unroll
        for (int r = 0; r < 4; ++r) {
            const float rcu = bflo(c_rc[r]), kcu = bflo(c_kc[r]), vcu = bflo(c_vc[r]);
            const float rpv = bflo(r == 0 ? c_rp : c_rc[r > 0 ? r - 1 : 0]), kpv = bflo(r == 0 ? c_kp : c_kc[r > 0 ? r - 1 : 0]), vpv = bflo(r == 0 ? c_vp : c_vc[r > 0 ? r - 1 : 0]);
            const float rr = rcu + (rpv - rcu) * mur, kx = kcu + (kpv - kcu) * muk; vx_[r] = vcu + (vpv - vcu) * muv;
            dec_[r] = __expf(-0.60653066f * rcp_f(1.f + __expf(-(cw0 + accw[r]))));
            const float ic = rcp_f(1.f + __expf(-(ca0 + acca[r])));
            const float kkn = kx * ckk * c_rn[r], k2 = kx * (1.f + (ic - 1.f) * cka), bv = kkn * ic;
            rr_[r] = rr; kkn_[r] = kkn; k2_[r] = k2; bv_[r] = bv;
            pbo_[r] = reduce16(rr * k2 * crk); }
#pragma unroll
        for (int pl = 0; pl < 2; ++pl) { const int r0 = 2 * pl, r1 = r0 + 1; const float wr1 = dec_[r1] * rr_[r1];
            psc_[pl][0] = reduce16(bv_[r0] * rr_[r0]); psc_[pl][1] = reduce16(k2_[r0] * rr_[r0]);
            psc_[pl][2] = reduce16(-bv_[r0] * kkn_[r1]); psc_[pl][3] = reduce16(-k2_[r0] * kkn_[r1]);
            psc_[pl][4] = reduce16(bv_[r0] * wr1); psc_[pl][5] = reduce16(k2_[r0] * wr1);
            psc_[pl][6] = reduce16(bv_[r1] * rr_[r1]); psc_[pl][7] = reduce16(k2_[r1] * rr_[r1]); }
        if (cc == 0) {
#pragma unroll
            for (int r = 0; r < 4; ++r) *(LAS float*)(B_ + P_BON + ((4 * hq + r) * 4 + hw) * 4) = pbo_[r];
#pragma unroll
            for (int pl = 0; pl < 2; ++pl)
#pragma unroll
                for (int e = 0; e < 8; ++e) *(LAS float*)(B_ + P_SC + (((2 * hq + pl) * 8 + e) * 4 + hw) * 4) = psc_[pl][e]; }
        { float D_[4], Dp_[4]; const float p0 = dec_[0], p1 = p0 * dec_[1], p2 = p1 * dec_[2], p3 = p2 * dec_[3];
          const float g0 = __shfl(p3, cc), g1 = __shfl(p3, cc + 16), g2 = __shfl(p3, cc + 32);
          const float E_ = hq == 0 ? 1.f : (hq == 1 ? g0 : (hq == 2 ? g0 * g1 : g0 * g1 * g2));
          D_[0] = E_ * p0; D_[1] = E_ * p1; D_[2] = E_ * p2; D_[3] = E_ * p3; Dp_[0] = E_; Dp_[1] = D_[0]; Dp_[2] = D_[1]; Dp_[3] = D_[2];
#pragma unroll
          for (int r = 0; r < 4; ++r) { const int pr_ = 2 * hq + (r >> 1), od = r & 1; const float rcp = rcp_f(D_[r]);
            const unsigned pw_ = pk2(-kkn_[r] * Dp_[r], D_[r] * rr_[r]);
            *(LAS bf16*)(B_ + I_PA + pr_ * 512 + od * 128 + pa_w) = (bf16)(pw_ & 0xffffu); *(LAS bf16*)(B_ + I_PA + pr_ * 512 + od * 128 + 64 + pa_w) = (bf16)(pw_ >> 16);
            *(LAS unsigned*)(B_ + I_A2 + (pr_ * 64 + ch) * 8 + od * 4) = pk2(bv_[r] * rcp, k2_[r] * rcp); *(LAS float*)(B_ + I_V + (pr_ * 64 + ch) * 8 + od * 4) = vx_[r]; }
          if (hq == 3) *(LAS float*)(B_ + I_DE + ch * 4) = D_[3]; }
        WG_BAR();
        unsigned char* gi = img_ptr(a.ws, chain, c0 + k);
#pragma unroll
        for (int i = 0; i < 3; ++i) *(v4u*)(gi + (tg + 256 * i) * 16) = *(const LAS v4u*)(B_ + (tg + 256 * i) * 16);
        if (tg < 16) *(v4u*)(gi + I_DE + tg * 16) = *(const LAS v4u*)(B_ + I_DE + tg * 16);
        else if (tg < 36) { const int j_ = tg - 16;
            const LAS unsigned char* pp_ = B_ + (j_ < 16 ? P_SC + j_ * 64 : P_BON + (j_ - 16) * 64);
            f32x4 o_;
#pragma unroll
            for (int e = 0; e < 4; ++e) { const f32x4 q_ = *(const LAS f32x4*)(pp_ + e * 16); o_[e] = (q_[0] + q_[1]) + (q_[2] + q_[3]); }
            *(f32x4*)(gi + (j_ < 16 ? I_SC + j_ * 16 : I_BON + (j_ - 16) * 16)) = o_; }
    }
    WG_BAR();
#undef H_LOAD
#undef H_ADV
}

constexpr int O_Y = 3 * IMG;
__device__ __forceinline__ void rwkv_block(LAS unsigned char* lds, const Args& a, int chain, int cbeg, int cend, f32x4 (&st)[4], int tid, int wave, int lane, int gate_chunk, unsigned* gate_flag) {
    const int b = chain >> 4, hh = chain & 15, rowbase = b * T;
    if (wave < 4) {
        const int i = lane & 15, hq = lane >> 4, n = 16 * wave + i;
        const unsigned hmask = hq == 0 ? 0xffffffffu : 0u;
        const int pa_off = (i & 3) * 64 + hq * 16;
        const f32x4 zero4 = (f32x4){0.f, 0.f, 0.f, 0.f};
        WG_BAR();
        __builtin_amdgcn_s_setprio(3);
        int bi = 0;
        for (int c = cbeg; c < cend; ++c) {
            LAS unsigned char* B = lds + bi * IMG;
            LAS unsigned char* Yb = lds + O_Y + (c & 1) * 4096;
            const float scv = *(const LAS float*)(B + I_SC + lane * 4);
            bf16x8 pa0 = *(const LAS bf16x8*)(B + I_PA + pa_off), pa1 = *(const LAS bf16x8*)(B + I_PA + 256 + pa_off);
            f32x2 v2 = *(const LAS f32x2*)(B + I_V + n * 8);
            v2u a2[4];
#pragma unroll
            for (int q = 0; q < 4; ++q) a2[q] = *(const LAS v2u*)(B + I_A2 + (16 * q + i) * 8);
#pragma unroll
            for (int pp = 0; pp < TC / 2; ++pp) {
                bf16x8 npa0 = pa0, npa1 = pa1; f32x2 nv2 = v2; v2u na2[4];
#pragma unroll
                for (int q = 0; q < 4; ++q) na2[q] = a2[q];
                if (pp + 1 < TC / 2) {
                    npa0 = *(const LAS bf16x8*)(B + I_PA + ((pp + 1) * 2 + 0) * 256 + pa_off); npa1 = *(const LAS bf16x8*)(B + I_PA + ((pp + 1) * 2 + 1) * 256 + pa_off);
                    nv2 = *(const LAS f32x2*)(B + I_V + ((pp + 1) * 64 + n) * 8);
#pragma unroll
                    for (int q = 0; q < 4; ++q) na2[q] = *(const LAS v2u*)(B + I_A2 + ((pp + 1) * 64 + 16 * q + i) * 8);
                }
                __builtin_amdgcn_sched_barrier(0);
                v4u s0, s1;
                s0.x = pk2(st[0][0], st[0][1]); s0.y = pk2(st[0][2], st[0][3]); s0.z = pk2(st[1][0], st[1][1]); s0.w = pk2(st[1][2], st[1][3]);
                s1.x = pk2(st[2][0], st[2][1]); s1.y = pk2(st[2][2], st[2][3]); s1.z = pk2(st[3][0], st[3][1]); s1.w = pk2(st[3][2], st[3][3]);
                const f32x4 d0 = __builtin_amdgcn_mfma_f32_16x16x32_bf16(pa0, __builtin_bit_cast(bf16x8, s0), zero4, 0, 0, 0);
                const f32x4 d1 = __builtin_amdgcn_mfma_f32_16x16x32_bf16(pa1, __builtin_bit_cast(bf16x8, s1), zero4, 0, 0, 0);
                const f32x4 d = d0 + d1;
                float sc[8];
#pragma unroll
                for (int e = 0; e < 8; ++e) sc[e] = __builtin_bit_cast(float, __builtin_amdgcn_readlane(__builtin_bit_cast(int, scv), pp * 8 + e));
                const float sa0 = d[0];
                const float sa1 = d[2] + sa0 * sc[2] + v2[0] * sc[3];
                *(LAS float*)(Yb + ((2 * pp) * 64 + n) * 4) = d[1] + sa0 * sc[0] + v2[0] * sc[1];
                *(LAS float*)(Yb + ((2 * pp + 1) * 64 + n) * 4) = (d[3] + sa0 * sc[4] + v2[0] * sc[5]) + (sa1 * sc[6] + v2[1] * sc[7]);
                v2u bw; bw.x = pk2(sa0, v2[0]) & hmask; bw.y = pk2(sa1, v2[1]) & hmask;
                const s16x4 bfr = __builtin_bit_cast(s16x4, bw);
#pragma unroll
                for (int q = 0; q < 4; ++q) st[q] = __builtin_amdgcn_mfma_f32_16x16x16bf16_1k(__builtin_bit_cast(s16x4, a2[q]), bfr, st[q], 0, 0, 0);
                pa0 = npa0; pa1 = npa1; v2 = nv2;
#pragma unroll
                for (int q = 0; q < 4; ++q) a2[q] = na2[q];
            }
#pragma unroll
            for (int q = 0; q < 4; ++q) st[q] = st[q] * *(const LAS f32x4*)(B + I_DE + (16 * q + 4 * hq) * 4);
            bi = bi == 2 ? 0 : bi + 1;
            WG_BAR();
        }
        __builtin_amdgcn_s_setprio(0);
    } else {
        const bf16* P = (const bf16*)(a.ws + WS_PROJ); bf16* mix = (bf16*)(a.ws + WS_H);
        const int hw = wave - 4, cc = lane & 15, hq = lane >> 4, ch = 16 * hw + cc, col = hh * 64 + ch, tg = tid - 256;
        const float clw = a.in[17][col], clb = a.in[18][col];
        const unsigned char* ibase = img_ptr(a.ws, chain, 0);
        const bf16x8 ones8 = __builtin_bit_cast(bf16x8, (v4u){0x3f803f80u, 0x3f803f80u, 0x3f803f80u, 0x3f803f80u});
        v4u imA[3], itA = (v4u){0u, 0u, 0u, 0u}, imB[3], itB = (v4u){0u, 0u, 0u, 0u}; unsigned gE[4] = {0u, 0u, 0u, 0u}, gO[4] = {0u, 0u, 0u, 0u};
#define I_LOAD(im, it, k) do { const unsigned go_ = (unsigned)((k) * IMG); \
        _Pragma("unroll") for (int i_ = 0; i_ < 3; ++i_) im[i_] = *(const v4u*)(ibase + (go_ + (unsigned)((tg + 256 * i_) * 16))); \
        if (tg < 36) it = *(const v4u*)(ibase + (go_ + (unsigned)(I_DE + tg * 16))); } while (0)
#define I_STORE(im, it, bix) do { LAS unsigned char* B_ = lds + (bix) * IMG; \
        _Pragma("unroll") for (int i_ = 0; i_ < 3; ++i_) *(LAS v4u*)(B_ + (tg + 256 * i_) * 16) = im[i_]; \
        if (tg < 36) *(LAS v4u*)(B_ + I_DE + tg * 16) = it; } while (0)
#define H_GLOAD(gx, k) do { const unsigned pg_ = (unsigned)((rowbase + (k) * TC + 4 * hq) * NP + C_GR + col); \
        _Pragma("unroll") for (int r = 0; r < 4; ++r) gx[r] = P[pg_ + (unsigned)(r * NP)]; } while (0)
#define H_POST(gx, k, bix) do { LAS unsigned char* B_ = lds + (bix) * IMG; LAS unsigned char* Y_ = lds + O_Y + ((k) & 1) * 4096; \
          \
        f32x4 s1_ = (f32x4){0.f, 0.f, 0.f, 0.f}, s2_ = (f32x4){0.f, 0.f, 0.f, 0.f}; \
        _Pragma("unroll") for (int kb = 0; kb < 2; ++kb) { \
            const f32x4 ya = *(const LAS f32x4*)(Y_ + (cc * 64 + 32 * kb + 8 * hq) * 4), yb = *(const LAS f32x4*)(Y_ + (cc * 64 + 32 * kb + 8 * hq + 4) * 4); \
            v4u f1, f2; f1.x = pk2(ya[0], ya[1]); f1.y = pk2(ya[2], ya[3]); f1.z = pk2(yb[0], yb[1]); f1.w = pk2(yb[2], yb[3]); \
            f2.x = pk2(ya[0] * ya[0], ya[1] * ya[1]); f2.y = pk2(ya[2] * ya[2], ya[3] * ya[3]); f2.z = pk2(yb[0] * yb[0], yb[1] * yb[1]); f2.w = pk2(yb[2] * yb[2], yb[3] * yb[3]); \
            s1_ = __builtin_amdgcn_mfma_f32_16x16x32_bf16(__builtin_bit_cast(bf16x8, f1), ones8, s1_, 0, 0, 0); \
            s2_ = __builtin_amdgcn_mfma_f32_16x16x32_bf16(__builtin_bit_cast(bf16x8, f2), ones8, s2_, 0, 0, 0); } \
        _Pragma("unroll") for (int r = 0; r < 4; ++r) { const int t_ = 4 * hq + r; \
            const float yo = *(const LAS float*)(Y_ + (t_ * 64 + ch) * 4), vv = *(const LAS float*)(B_ + I_V + ((t_ >> 1) * 64 + ch) * 8 + (t_ & 1) * 4), bon = *(const LAS float*)(B_ + I_BON + t_ * 4); \
            const float mean = s1_[r] * (1.f / 64.f), var = fmaxf(s2_[r] * (1.f / 64.f) - mean * mean, 0.f), rs = rsqrtf(var + 64e-5f); \
            const float o_ = ((yo - mean) * rs * clw + clb + bon * vv) * silu_f(bflo(gx[r])); \
            mix[(unsigned)((rowbase + (k) * TC + t_) * D + 1024 + col)] = (bf16)(pk2(o_, o_) & 0xffffu); } \
    } while (0)
        I_LOAD(imA, itA, cbeg); I_STORE(imA, itA, 0);
        I_LOAD(imA, itA, cbeg + 1); I_LOAD(imB, itB, cbeg + 2);
        H_GLOAD(gE, cbeg);
        WG_BAR();
        int bi = 0;
        for (int c = cbeg; c < cend; c += 2) {
            if (c + 4 == gate_chunk) {
                unsigned sp_ = 0;
                while (__hip_atomic_load(gate_flag, __ATOMIC_RELAXED, __HIP_MEMORY_SCOPE_AGENT) == 0u) { __builtin_amdgcn_s_sleep(4); if (++sp_ > (1u << 22)) break; }
                __builtin_amdgcn_fence(__ATOMIC_ACQUIRE, "agent");
                asm volatile("s_waitcnt vmcnt(0)" ::: "memory");
            }
            {
                const int bn = bi == 2 ? 0 : bi + 1, bp = bi == 0 ? 2 : bi - 1;
                I_STORE(imA, itA, bn); if (c + 3 < cend) I_LOAD(imA, itA, c + 3);
                if (c > cbeg) H_POST(gO, c - 1, bp);
                H_GLOAD(gO, c + 1);
                bi = bn;
                WG_BAR();
            }
            {
                const int bn = bi == 2 ? 0 : bi + 1, bp = bi == 0 ? 2 : bi - 1;
                if (c + 2 < cend) { I_STORE(imB, itB, bn); if (c + 4 < cend) I_LOAD(imB, itB, c + 4); }
                H_POST(gE, c, bp);
                if (c + 2 < cend) H_GLOAD(gE, c + 2);
                bi = bn;
                WG_BAR();
            }
        }
        H_POST(gO, cend - 1, (bi == 0 ? 2 : bi - 1));
#undef I_LOAD
#undef I_STORE
#undef H_GLOAD
#undef H_POST
    }
    WG_BAR();
}

__device__ __forceinline__ void phase5(const Args& a, int wave, int lane) {
    const float* x = a.in[0]; const float* g = a.in[5];
    const float* mod = (const float*)(a.ws + WS_MOD); const bf16* MO = (const bf16*)(a.ws + WS_MIXOUT);
    const int gw = blockIdx.x * NWAVES + wave, NGW = gridDim.x * NWAVES;
    for (int m = gw; m < M; m += NGW) {
        const int b = m >> 11;
        const v4u* mr = (const v4u*)(MO + (size_t)m * D) + lane;
        const f32x4* xr = (const f32x4*)(x + (size_t)m * D);
        v4u mv[4]; f32x4 xv[8]; float ss = 0.f;
#pragma unroll
        for (int j = 0; j < 4; ++j) mv[j] = mr[64 * j];
#pragma unroll
        for (int j = 0; j < 4; ++j) { xv[2 * j] = xr[128 * j + 2 * lane]; xv[2 * j + 1] = xr[128 * j + 2 * lane + 1]; }
#pragma unroll
        for (int j = 0; j < 4; ++j)
#pragma unroll
            for (int e = 0; e < 4; ++e) { const float lo = bflo(mv[j][e]), hi = bfhi(mv[j][e]); ss += lo * lo + hi * hi; }
        const float rinv = rsqrtf(wave_sum(ss) * (1.f / D) + 1e-6f);
        f32x4* orow = (f32x4*)(a.out + (size_t)m * D);
#pragma unroll
        for (int j = 0; j < 4; ++j)
#pragma unroll
            for (int h = 0; h < 2; ++h) {
                const int col = 512 * j + 8 * lane + 4 * h;
                const f32x4 g4 = *(const f32x4*)(g + col);
                const f32x4 gt = *(const f32x4*)(mod + b * 6144 + 4096 + col);
                const f32x4 v = (f32x4){bflo(mv[j][2 * h]), bfhi(mv[j][2 * h]), bflo(mv[j][2 * h + 1]), bfhi(mv[j][2 * h + 1])};
                orow[128 * j + 2 * lane + h] = xv[2 * j + h] + gt * (v * rinv * g4);
            }
    }
}

__device__ __forceinline__ void sub_barrier(unsigned* cnt, unsigned expect) {
    asm volatile("s_waitcnt vmcnt(0)" ::: "memory");
    __syncthreads();
    if (threadIdx.x == 0) {
        __builtin_amdgcn_fence(__ATOMIC_RELEASE, "agent");
        asm volatile("s_waitcnt vmcnt(0)" ::: "memory");
        __hip_atomic_fetch_add(cnt, 1u, __ATOMIC_RELAXED, __HIP_MEMORY_SCOPE_AGENT);
        unsigned sp = 0;
        while (__hip_atomic_load(cnt, __ATOMIC_RELAXED, __HIP_MEMORY_SCOPE_AGENT) < expect) { __builtin_amdgcn_s_sleep(2); if (++sp > (1u << 22)) break; }
        __builtin_amdgcn_fence(__ATOMIC_ACQUIRE, "agent");
        asm volatile("s_waitcnt vmcnt(0)" ::: "memory");
    }
    __syncthreads();
}

__global__ void __launch_bounds__(NWAVES * 64, 2) hymba_fwd(Args a) {
    extern __shared__ __attribute__((aligned(16))) unsigned char lds_raw[];
    LAS unsigned char* lds = (LAS unsigned char*)lds_raw;
    cg::grid_group grid = cg::this_grid();
    volatile LAS unsigned* xst = (volatile LAS unsigned*)(lds + 131072 + 512);
    if (threadIdx.x < 2) xst[threadIdx.x] = 0u;
    __syncthreads();
    const XcdBarrier xbar = xcd_barrier_post((unsigned*)(a.ws + WS_CTL), xst);
#define GRID_SYNC_CG() do { asm volatile("s_waitcnt vmcnt(0)" ::: "memory"); grid.sync(); } while (0)
#define GRID_SYNC() xcd_barrier(xbar)
    const int tid = threadIdx.x, lane = tid & 63, wave = __builtin_amdgcn_readfirstlane(tid >> 6);

    if (a.out == nullptr) GRID_SYNC_CG();
    phase0(lds, a, tid, wave, lane);
    GRID_SYNC();
    phase1(a, wave, lane);
    GRID_SYNC();
    {
        pg8::Gemm g{(const pg8::bf16_t*)(a.ws + WS_H), (const pg8::bf16_t*)(a.ws + WS_WIN), M, NP, D};
        pg8::StaticOrder S; S.init(M, NP, (int)gridDim.x, (int)blockIdx.x);
        pg8::EpiBf16<0> E{(pg8::bf16_t*)(a.ws + WS_PROJ), NP, nullptr, 0, 0, 1.f};
        pg8::gemm_phase<pg8::EpiBf16<0>, pg8::StaticOrder, true, true>(lds, g, S, E);
    }
    GRID_SYNC();
    phase25(a, wave, lane);
    GRID_SYNC();
    rwkv_prepass(lds, a, tid, wave, lane, 0, 64, 256, (int)blockIdx.x);
    GRID_SYNC();
    {
        unsigned* flags = (unsigned*)(a.ws + WS_CTL) + 3600;
        if (blockIdx.x < 128) {
            f32x4 st[4];
#pragma unroll
            for (int q = 0; q < 4; ++q) st[q] = (f32x4){0.f, 0.f, 0.f, 0.f};
            rwkv_block(lds, a, (int)blockIdx.x, 0, 128, st, tid, wave, lane, 64, flags + blockIdx.x);
        } else {
            const bf16* P = (const bf16*)(a.ws + WS_PROJ); bf16* mix = (bf16*)(a.ws + WS_H);
            const int bxo = (int)blockIdx.x - 128;
            rwkv_prepass(lds, a, tid, wave, lane, 64, 64, 128, bxo);
            asm volatile("s_waitcnt vmcnt(0)" ::: "memory");
            __syncthreads();
            if (tid == 0) { __builtin_amdgcn_fence(__ATOMIC_RELEASE, "agent"); asm volatile("s_waitcnt vmcnt(0)" ::: "memory");
                __hip_atomic_store(flags + bxo, 1u, __ATOMIC_RELAXED, __HIP_MEMORY_SCOPE_AGENT); }
            attn_phase(lds, P, mix, a.in[8], bxo, 128, 4, tid, wave, lane);
        }
        GRID_SYNC();
    }
    {
        pg8::Gemm g{(const pg8::bf16_t*)(a.ws + WS_H), (const pg8::bf16_t*)(a.ws + WS_WOUT), M, D, D};
        pg8::StaticOrder S; S.init(M, D, (int)gridDim.x, (int)blockIdx.x);
        pg8::EpiBf16<0> E{(pg8::bf16_t*)(a.ws + WS_MIXOUT), D, nullptr, 0, 0, 1.f};
        pg8::gemm_phase<pg8::EpiBf16<0>, pg8::StaticOrder, true, true>(lds, g, S, E);
    }
    GRID_SYNC();
    phase5(a, wave, lane);
}

extern "C" void kernel_launch(void* const* d_in, const int* in_sizes, int n_in, void* d_out, int out_size, void* d_ws, size_t ws_size, hipStream_t stream) {
    static int grid = 0;
    if (grid == 0) {
        if (n_in != 19 || out_size != M * D || ws_size < WS_END) { fprintf(stderr, "kernel_launch: unexpected shapes (n_in %d out %d ws %zu)\n", n_in, out_size, ws_size); grid = -1; return; }
        int dev = 0, cus = 0, per_cu = 0;
        (void)hipGetDevice(&dev); (void)hipDeviceGetAttribute(&cus, hipDeviceAttributeMultiprocessorCount, dev);
        (void)hipFuncSetAttribute((const void*)hymba_fwd, hipFuncAttributeMaxDynamicSharedMemorySize, LDS_BYTES);
        (void)hipOccupancyMaxActiveBlocksPerMultiprocessor(&per_cu, (const void*)hymba_fwd, NWAVES * 64, LDS_BYTES);
        (void)hipGetLastError();
        grid = cus > 0 ? cus : 256;
        if (per_cu < 1) fprintf(stderr, "kernel_launch: occupancy query says %d blocks per CU\n", per_cu);
    }
    if (grid < 0) return;
    if (hipMemsetAsync((char*)d_ws + WS_CTL, 0, CTL_BYTES, stream) != hipSuccess) { fprintf(stderr, "kernel_launch: memset of the barrier words failed\n"); return; }
    Args a{};
    for (int i = 0; i < 19; ++i) a.in[i] = (const float*)d_in[i];
    a.out = (float*)d_out; a.ws = (unsigned char*)d_ws;
    void* args[] = {&a};
    hipError_t e = hipLaunchCooperativeKernel((const void*)hymba_fwd, dim3(grid), dim3(NWAVES * 64), args, LDS_BYTES, stream);
    if (e != hipSuccess) fprintf(stderr, "cooperative launch failed: %s (grid %d)\n", hipGetErrorString(e), grid);
}
```

```cpp
#include <hip/hip_runtime.h>
#include <hip/hip_cooperative_groups.h>
#include <cstdio>
#include <cstdint>
namespace cg = cooperative_groups;
namespace pg8 {
#define PG8_LAS __attribute__((address_space(3)))
typedef unsigned short bf16_t;
typedef short bf16x8 __attribute__((ext_vector_type(8)));
typedef float f32x4 __attribute__((ext_vector_type(4)));
typedef unsigned u32x4 __attribute__((ext_vector_type(4)));
constexpr int BM = 256, BK = 64, HALF = 128, HTB = HALF * BK * 2  , STAGE_BYTES = 8 * HTB, NXCD = 8, WGM = 8;

__host__ __device__ __forceinline__ int lds_byte(int r, int c) { const int st = (r >> 4) * 2 + (c >> 5), rr = r & 15, cc = c & 31, ob = rr * 64 + cc * 2; return st * 1024 + (ob ^ (((ob >> 9) & 1) << 5)); }
__host__ __device__ __forceinline__ void stage_rc(int b, int& R, int& C) { const int st = b / 1024, sb = b % 1024, swz = sb ^ (((sb >> 9) & 1) << 5); R = (st >> 1) * 16 + swz / 64; C = (st & 1) * 32 + (swz % 64) / 2; }
__host__ __device__ __forceinline__ int perm32(int rho) { const int n = rho >> 4, i = rho & 15; return 8 * (i >> 2) + 4 * n + (i & 3); }

struct Unit { int pm, pn; };
struct Gemm { const bf16_t* A; const bf16_t* Bt; int M, N, K; };

struct StaticOrder {
    int nM, nN, nwg, G, c;
    __host__ __device__ void init(int M, int N, int G_, int c_) { nM = M / BM; nN = N / BM; nwg = nM * nN; G = G_; c = c_; }
    __host__ __device__ bool next(int i, Unit& u) const {
        const long L = (long)i * G + c; if (L >= nwg) return false;
        int wgid = (int)L; { const int q = nwg / NXCD, r = nwg % NXCD, xcd = wgid % NXCD, off = wgid / NXCD; wgid = (xcd < r ? xcd * (q + 1) : r * (q + 1) + (xcd - r) * q) + off; }
        const int nig = WGM * nN, gid = wgid / nig, fm = gid * WGM, gsz = (nM - fm) < WGM ? (nM - fm) : WGM;
        u.pm = fm + ((wgid % nig) % gsz); u.pn = (wgid % nig) / gsz; return true;
    }
    __device__ __forceinline__ void a_ready(const Unit&) const {}
    __device__ __forceinline__ void done(const Unit&) const {}
};

typedef __bf16 bf16x2n_t __attribute__((ext_vector_type(2))); typedef float f32x2n_t __attribute__((ext_vector_type(2)));
__device__ __forceinline__ unsigned cvt_pk_bf16(float lo, float hi) { const f32x2n_t v = {lo, hi}; return __builtin_bit_cast(unsigned, __builtin_convertvector(v, bf16x2n_t)); }
typedef float f32x2 __attribute__((ext_vector_type(2)));
__device__ __forceinline__ f32x2 gelu_pk(f32x2 v) {
    const f32x2 av = __builtin_elementwise_abs(v), d = av * 0.2316418882f + 1.0f;
    f32x2 t; t.x = __builtin_amdgcn_rcpf(d.x); t.y = __builtin_amdgcn_rcpf(d.y);
    f32x2 q = t * 0.5307027145f + (-0.7265760135f); q = q * t + 0.7107068705f; q = q * t + (-0.142248368f); q = q * t + 0.127414796f; q = q * t;
    const f32x2 s = (v * v) * (-0.72134752044f);
    f32x2 e; e.x = __builtin_amdgcn_exp2f(s.x); e.y = __builtin_amdgcn_exp2f(s.y);
    const f32x2 m = v * (q * e), r = v - m;
    f32x2 o; o.x = v.x < 0.f ? m.x : r.x; o.y = v.y < 0.f ? m.y : r.y; return o;
}

template <int ACT  > struct EpiBf16 {
    static constexpr bool PERM = true, AFTER_DRAIN = false; static_assert(ACT == 0 || ACT == 1, "EpiBf16: ACT is 0 (none) or 1 (gelu_pk)");
    bf16_t* O; int ldc; const float* bias; int split_cols; size_t split_stride; float scale0;
    __device__ __forceinline__ void operator()(const f32x4 (&acc)[2][2][4][2], const Unit& u, int wr, int wc, int fr, int fq) const {
        const int row0 = u.pm * BM + wr * 64 + fr; int colt = u.pn * BM; bf16_t* base = O;
        float sc = 1.f; if (split_cols) { const int t = colt / split_cols; base += (size_t)t * split_stride; colt -= t * split_cols; if (t == 0) sc = scale0; }
        const int col0 = colt + wc * 32 + 8 * fq, bcol0 = u.pn * BM + wc * 32 + 8 * fq;
        f32x4 bv[2][2];
#pragma unroll
        for (int bj = 0; bj < 2; ++bj)
#pragma unroll
            for (int n = 0; n < 2; ++n) bv[bj][n] = bias ? *(const f32x4*)(bias + bcol0 + bj * HALF + 4 * n) : (f32x4){0.f, 0.f, 0.f, 0.f};
#pragma unroll
        for (int ai = 0; ai < 2; ++ai)
#pragma unroll
            for (int m = 0; m < 4; ++m) { bf16_t* rowp = base + (size_t)(row0 + ai * HALF + m * 16) * ldc + col0;
#pragma unroll
                for (int bj = 0; bj < 2; ++bj) { f32x4 v0 = acc[ai][bj][m][0] + bv[bj][0], v1 = acc[ai][bj][m][1] + bv[bj][1];
                    if (ACT == 1) { f32x2 a = gelu_pk((f32x2){v0[0], v0[1]}), b = gelu_pk((f32x2){v0[2], v0[3]}), c = gelu_pk((f32x2){v1[0], v1[1]}), d = gelu_pk((f32x2){v1[2], v1[3]});
                        v0 = (f32x4){a.x, a.y, b.x, b.y}; v1 = (f32x4){c.x, c.y, d.x, d.y}; }
                    v0 = v0 * sc; v1 = v1 * sc; u32x4 w; w.x = cvt_pk_bf16(v0[0], v0[1]); w.y = cvt_pk_bf16(v0[2], v0[3]); w.z = cvt_pk_bf16(v1[0], v1[1]); w.w = cvt_pk_bf16(v1[2], v1[3]);
                    *(u32x4*)(rowp + bj * HALF) = w; } }
    }
};
struct EpiF32 {
    static constexpr bool PERM = false, AFTER_DRAIN = false;
    float* O; int ldc;
    __device__ __forceinline__ void operator()(const f32x4 (&acc)[2][2][4][2], const Unit& u, int wr, int wc, int fr, int fq) const {
        const int col0 = u.pn * BM + wc * 32 + 4 * fq;
#pragma unroll
        for (int ai = 0; ai < 2; ++ai)
#pragma unroll
            for (int m = 0; m < 4; ++m) { float* rowp = O + (size_t)(u.pm * BM + ai * HALF + wr * 64 + m * 16 + fr) * ldc + col0;
#pragma unroll
                for (int bj = 0; bj < 2; ++bj)
#pragma unroll
                    for (int n = 0; n < 2; ++n) *(f32x4*)(rowp + bj * HALF + n * 16) = acc[ai][bj][m][n]; }
    }
};
template <class Epi, class Sched, bool ALIGN_EPI = false, bool SP2 = false>
__device__ __forceinline__ void gemm_phase(PG8_LAS unsigned char* lds, const Gemm g, const Sched& S, const Epi& E) {
    const int tid = threadIdx.x, wid = __builtin_amdgcn_readfirstlane(tid >> 6), lane = tid & 63, wr = wid >> 2, wc = wid & 3, fr = lane & 15, fq = lane >> 4;
    const int K = g.K, nt = K / BK;
    unsigned voffA[2], voffB[2];
#pragma unroll
    for (int i = 0; i < 2; ++i) { int R, C; stage_rc(tid * 16 + i * 8192, R, C); const int Rb = Epi::PERM ? ((R & ~31) + perm32(R & 31)) : R;
        voffA[i] = (unsigned)(R * K + C) * 2u; voffB[i] = (unsigned)(Rb * K + C) * 2u; }
    const size_t kstep = (size_t)(BK * 2);
    const size_t hstep = (size_t)HALF * K * 2;
    const size_t tstep = 2 * hstep;
    const unsigned ldsw = (unsigned)wid * 1024u;
    const int aoff = lds_byte(wr * 64 + fr, fq * 8), boff = lds_byte(wc * 32 + fr, fq * 8);
#define PG8_SA(b, h) (((b) * 2 + (h)) * HTB)
#define PG8_SB(b, h) ((4 + (b) * 2 + (h)) * HTB)
#define PG8_STAGE(bufoff, gbase, voff) do { _Pragma("unroll") for (int _i = 0; _i < 2; ++_i) \
        __builtin_amdgcn_global_load_lds((const unsigned*)((const char*)(gbase) + (voff)[_i]), (PG8_LAS unsigned*)(lds + (bufoff) + ldsw + _i * 8192), 16, 0, 0); } while (0)
#define PG8_LDA(dst, b, h) do { _Pragma("unroll") for (int m = 0; m < 4; ++m) _Pragma("unroll") for (int k = 0; k < 2; ++k) dst[m][k] = *(const PG8_LAS bf16x8*)(lds + PG8_SA(b, h) + aoff + m * 2048 + k * 1024); } while (0)
#define PG8_LDB(dst, b, h) do { _Pragma("unroll") for (int n = 0; n < 2; ++n) _Pragma("unroll") for (int k = 0; k < 2; ++k) dst[n][k] = *(const PG8_LAS bf16x8*)(lds + PG8_SB(b, h) + boff + n * 2048 + k * 1024); } while (0)
#define PG8_MMA(ai, bj, At, Bt) do { __builtin_amdgcn_s_setprio(1); _Pragma("unroll") for (int m = 0; m < 4; ++m) _Pragma("unroll") for (int n = 0; n < 2; ++n) _Pragma("unroll") for (int k = 0; k < 2; ++k) \
        acc[ai][bj][m][n] = __builtin_amdgcn_mfma_f32_16x16x32_bf16(Bt[n][k], At[m][k], acc[ai][bj][m][n], 0, 0, 0); __builtin_amdgcn_s_setprio(0); } while (0)
#define PG8_WAIT_V(n) asm volatile("s_waitcnt vmcnt(" #n ")" ::: "memory")
#define PG8_WAIT_L(n) asm volatile("s_waitcnt lgkmcnt(" #n ")" ::: "memory")
#define PG8_BAR __builtin_amdgcn_s_barrier()
#define PG8_SCHED __builtin_amdgcn_sched_barrier(0)
    Unit cur, nxt; int ui = 0;
    if (!S.next(0, cur)) return;
    f32x4 acc[2][2][4][2];
#pragma unroll
    for (int a = 0; a < 2; ++a)
#pragma unroll
        for (int b = 0; b < 2; ++b)
#pragma unroll
            for (int m = 0; m < 4; ++m)
#pragma unroll
                for (int n = 0; n < 2; ++n) acc[a][b][m][n] = (f32x4){0.f, 0.f, 0.f, 0.f};
    bf16x8 At[4][2], B0[2][2], B1[2][2];
    const char* cA = (const char*)g.A + (size_t)cur.pm * tstep; const char* cB = (const char*)g.Bt + (size_t)cur.pn * tstep;
    S.a_ready(cur);
    if constexpr (SP2) {
        PG8_STAGE(PG8_SB(0, 0), cB, voffB); PG8_STAGE(PG8_SB(0, 1), cB + hstep, voffB); PG8_STAGE(PG8_SA(0, 0), cA, voffA); PG8_STAGE(PG8_SA(0, 1), cA + hstep, voffA);
        if (wr == 1) PG8_BAR;
        PG8_WAIT_V(2); PG8_BAR;
        PG8_STAGE(PG8_SB(1, 0), cB + kstep, voffB); PG8_STAGE(PG8_SA(1, 0), cA + kstep, voffA); PG8_STAGE(PG8_SB(1, 1), cB + hstep + kstep, voffB);
        PG8_WAIT_V(6); PG8_BAR;
    } else {
        PG8_STAGE(PG8_SB(0, 0), cB, voffB); PG8_STAGE(PG8_SA(0, 0), cA, voffA); PG8_STAGE(PG8_SB(0, 1), cB + hstep, voffB); PG8_STAGE(PG8_SA(0, 1), cA + hstep, voffA);
        if (wr == 1) PG8_BAR;
        PG8_WAIT_V(4); PG8_BAR;
        PG8_STAGE(PG8_SB(1, 0), cB + kstep, voffB); PG8_STAGE(PG8_SA(1, 0), cA + kstep, voffA); PG8_STAGE(PG8_SB(1, 1), cB + hstep + kstep, voffB);
        PG8_WAIT_V(6); PG8_BAR;
    }
    for (;;) {
        const bool has_next = S.next(ui + 1, nxt);
        const char* nA = has_next ? (const char*)g.A + (size_t)nxt.pm * tstep : cA; const char* nB = has_next ? (const char*)g.Bt + (size_t)nxt.pn * tstep : cB;
        for (int t = 0; t < nt; t += 2) {
            const bool last = (t == nt - 2);
            const char* a1 = cA + (size_t)(t + 1) * kstep;
            const char* a2 = last ? nA : cA + (size_t)(t + 2) * kstep; const char* b2 = last ? nB : cB + (size_t)(t + 2) * kstep;
            const char* a3 = a2 + kstep; const char* b3 = b2 + kstep;
            if (last && has_next) S.a_ready(nxt);
            if constexpr (SP2) {
            PG8_LDB(B0, 0, 0); PG8_LDB(B1, 0, 1); PG8_SCHED; PG8_LDA(At, 0, 0); PG8_STAGE(PG8_SA(1, 1), a1 + hstep, voffA);
            PG8_WAIT_V(8); PG8_WAIT_L(0); PG8_BAR; PG8_MMA(0, 0, At, B0); PG8_MMA(0, 1, At, B1); PG8_BAR; PG8_SCHED;
            PG8_LDA(At, 0, 1); PG8_STAGE(PG8_SB(0, 0), b2, voffB); PG8_STAGE(PG8_SB(0, 1), b2 + hstep, voffB); PG8_STAGE(PG8_SA(0, 0), a2, voffA);
            PG8_WAIT_V(8); PG8_WAIT_L(0); PG8_BAR; PG8_MMA(1, 0, At, B0); PG8_MMA(1, 1, At, B1); PG8_BAR; PG8_SCHED;
            PG8_LDB(B0, 1, 0); PG8_LDB(B1, 1, 1); PG8_SCHED; PG8_LDA(At, 1, 0); PG8_STAGE(PG8_SA(0, 1), a2 + hstep, voffA);
            PG8_WAIT_V(8); PG8_WAIT_L(0); PG8_BAR; PG8_MMA(0, 0, At, B0); PG8_MMA(0, 1, At, B1); PG8_BAR; PG8_SCHED;
            PG8_LDA(At, 1, 1); PG8_STAGE(PG8_SB(1, 0), b3, voffB); PG8_STAGE(PG8_SB(1, 1), b3 + hstep, voffB); PG8_STAGE(PG8_SA(1, 0), a3, voffA);
            PG8_WAIT_V(8); PG8_WAIT_L(0); PG8_BAR; PG8_MMA(1, 0, At, B0); PG8_MMA(1, 1, At, B1); PG8_BAR; PG8_SCHED;
            } else {
            PG8_LDB(B0, 0, 0); PG8_SCHED; PG8_LDA(At, 0, 0); PG8_STAGE(PG8_SA(1, 1), a1 + hstep, voffA);
            PG8_WAIT_L(8); PG8_BAR; PG8_WAIT_L(0); PG8_MMA(0, 0, At, B0); PG8_BAR; PG8_SCHED;
            PG8_LDB(B1, 0, 1); PG8_STAGE(PG8_SB(0, 0), b2, voffB);
            PG8_BAR; PG8_WAIT_L(0); PG8_MMA(0, 1, At, B1); PG8_BAR;
            PG8_LDA(At, 0, 1); PG8_STAGE(PG8_SA(0, 0), a2, voffA);
            PG8_BAR; PG8_WAIT_L(0); PG8_MMA(1, 0, At, B0); PG8_BAR; PG8_SCHED;
            PG8_STAGE(PG8_SB(0, 1), b2 + hstep, voffB);
            PG8_WAIT_V(6); PG8_BAR; PG8_MMA(1, 1, At, B1); PG8_BAR;
            PG8_LDB(B0, 1, 0); PG8_SCHED; PG8_LDA(At, 1, 0); PG8_STAGE(PG8_SA(0, 1), a2 + hstep, voffA);
            PG8_WAIT_L(8); PG8_BAR; PG8_WAIT_L(0); PG8_MMA(0, 0, At, B0); PG8_BAR; PG8_SCHED;
            PG8_LDB(B1, 1, 1); PG8_STAGE(PG8_SB(1, 0), b3, voffB);
            PG8_BAR; PG8_WAIT_L(0); PG8_MMA(0, 1, At, B1); PG8_BAR;
            PG8_LDA(At, 1, 1); PG8_STAGE(PG8_SA(1, 0), a3, voffA);
            PG8_BAR; PG8_WAIT_L(0); PG8_MMA(1, 0, At, B0); PG8_BAR; PG8_SCHED;
            PG8_STAGE(PG8_SB(1, 1), b3 + hstep, voffB);
            PG8_WAIT_V(6); PG8_BAR; PG8_MMA(1, 1, At, B1); PG8_BAR;
            }
        }
        if constexpr (ALIGN_EPI) { if (wr == 0) PG8_BAR; }
        if constexpr (!Epi::AFTER_DRAIN) { E(acc, cur, wr, wc, fr, fq); S.done(cur); }
        if (!has_next) break;
#pragma unroll
        for (int a = 0; a < 2; ++a)
#pragma unroll
            for (int b = 0; b < 2; ++b)
#pragma unroll
                for (int m = 0; m < 4; ++m)
#pragma unroll
                    for (int n = 0; n < 2; ++n) acc[a][b][m][n] = (f32x4){0.f, 0.f, 0.f, 0.f};
        cur = nxt; cA = nA; cB = nB; ++ui;
        if constexpr (ALIGN_EPI) { if (wr == 1) PG8_BAR; }
    }
    PG8_WAIT_V(0);
    if constexpr (!ALIGN_EPI) { if (wr == 0) PG8_BAR; }
    PG8_BAR;
    if constexpr (Epi::AFTER_DRAIN) { E.fused(acc, cur, wr, wc, fr, fq, lds, wid, lane); S.done(cur); }
#undef PG8_SA
#undef PG8_SB
#undef PG8_STAGE
#undef PG8_LDA
#undef PG8_LDB
#undef PG8_MMA
#undef PG8_WAIT_V
#undef PG8_WAIT_L
#undef PG8_BAR
#undef PG8_SCHED
}
}
#define GAS __attribute__((address_space(1)))
#define LAS __attribute__((address_space(3)))
typedef unsigned short bf16;
typedef unsigned v4u __attribute__((ext_vector_type(4)));
typedef unsigned v2u __attribute__((ext_vector_type(2)));
typedef float f32x4 __attribute__((ext_vector_type(4)));
typedef float f32x2 __attribute__((ext_vector_type(2)));
typedef short bf16x8 __attribute__((ext_vector_type(8)));
typedef short s16x4 __attribute__((ext_vector_type(4)));

constexpr int NB = 8, T = 2048, D = 2048, M = NB * T;
constexpr int NIN = 6784, NP = 6912;
constexpr int C_Q = 0, C_K = 1024, C_V = 1280, C_GA = 1536, C_R = 2560, C_RK = 3584, C_RV = 4608, C_WD = 5632, C_AD = 5696, C_GR = 5760;
constexpr size_t MiB = 1u << 20;
constexpr size_t WS_MOD = 0;
constexpr size_t WS_CTL = 512 * 1024, CTL_BYTES = 16384;
constexpr size_t WS_WIN = 2 * MiB;
constexpr size_t WS_WOUT = 29 * MiB;
constexpr size_t WS_H = 40 * MiB;
constexpr size_t WS_PROJ = 104 * MiB;
constexpr size_t WS_MIXOUT = 320 * MiB;
constexpr size_t WS_XW = 2 * MiB;
constexpr size_t WS_XA = 4 * MiB;
constexpr size_t WS_RN = 6 * MiB;
constexpr size_t WS_IMGA = 7 * MiB;
constexpr size_t WS_IMGB = 320 * MiB;
constexpr size_t WS_END = 500 * MiB;
constexpr int LDS_BYTES = 147456, RING_BYTES = 131072;
constexpr int NWAVES = 8;

__device__ __forceinline__ float rcp_f(float v) { return __builtin_amdgcn_rcpf(v); }
#define LDS_WAIT() asm volatile("s_waitcnt lgkmcnt(0)" ::: "memory")
__device__ __forceinline__ unsigned f2bf(float f) { unsigned u = __builtin_bit_cast(unsigned, f); return (u + 0x7fffu + ((u >> 16) & 1u)) >> 16; }
typedef __bf16 bf16x2_t __attribute__((ext_vector_type(2)));
__device__ __forceinline__ unsigned pk2(float lo, float hi) { const f32x2 v = {lo, hi}; return __builtin_bit_cast(unsigned, __builtin_convertvector(v, bf16x2_t)); }
__device__ __forceinline__ float tanh_f(float v) { return 1.f - 2.f * rcp_f(__expf(2.f * v) + 1.f); }
__device__ __forceinline__ float bflo(unsigned u) { return __builtin_bit_cast(float, u << 16); }
__device__ __forceinline__ float bfhi(unsigned u) { return __builtin_bit_cast(float, u & 0xffff0000u); }
__device__ __forceinline__ float silu_f(float v) { return v * rcp_f(1.f + __expf(-v)); }
__device__ __forceinline__ float wave_sum(float v) {
#pragma unroll
    for (int o = 1; o < 64; o <<= 1) v += __shfl_xor(v, o);
    return v;
}
template <int CTRL> __device__ __forceinline__ float dpp_add(float x) {
    const int y = __builtin_amdgcn_update_dpp(0, __builtin_bit_cast(int, x), CTRL, 0xF, 0xF, false);
    return x + __builtin_bit_cast(float, y);
}
__device__ __forceinline__ float reduce16(float x) {
    x = dpp_add<0x128>(x); x = dpp_add<0x124>(x); x = dpp_add<0x122>(x); x = dpp_add<0x121>(x);
    return x;
}
__device__ __forceinline__ float half_sum(float v) {
    v = reduce16(v); v += __shfl_xor(v, 16);
    return v;
}
struct Args { const float* in[19]; float* out; unsigned char* ws; };

__device__ __forceinline__ void p0_transpose_item(const float* W, int K, int N, bf16* WT, LAS float* scr, int item, int lane) {
    const int nblk = N / 32, kb = item / nblk, nb = item % nblk, k0 = 64 * kb, n0 = 32 * nb;
    float wv[32];
#pragma unroll
    for (int i = 0; i < 32; ++i) wv[i] = W[(size_t)(k0 + 2 * i + (lane >> 5)) * N + n0 + (lane & 31)];
#pragma unroll
    for (int i = 0; i < 32; ++i) scr[(2 * i + (lane >> 5)) * 33 + (lane & 31)] = wv[i];
    LDS_WAIT(); asm volatile("" ::: "memory");
    const int c = lane & 7;
#pragma unroll
    for (int j = 0; j < 4; ++j) { const int n = (lane >> 3) + 8 * j; const LAS float* s = scr + (8 * c) * 33 + n;
        v4u o; o.x = pk2(s[0 * 33], s[1 * 33]); o.y = pk2(s[2 * 33], s[3 * 33]); o.z = pk2(s[4 * 33], s[5 * 33]); o.w = pk2(s[6 * 33], s[7 * 33]);
        *(v4u*)(WT + (size_t)(n0 + n) * K + k0 + 8 * c) = o; }
    LDS_WAIT(); asm volatile("" ::: "memory");
}

__device__ __forceinline__ void phase0(LAS unsigned char* lds, const Args& a, int tid, int wave, int lane) {
    const float* c = a.in[1]; const float* w_ada = a.in[2]; const float* b_ada = a.in[3];
    float* mod = (float*)(a.ws + WS_MOD);
    if (blockIdx.x < 192) {
        LAS float* s = (LAS float*)lds;
        LAS float* red = s + 16384;
        for (int i = tid; i < 8 * 2048; i += 512) s[i] = silu_f(c[i]);
        __syncthreads();
        const int j = blockIdx.x, cgp = tid & 7, kp = tid >> 3;
        float acc[8][4];
#pragma unroll
        for (int b = 0; b < 8; ++b)
#pragma unroll
            for (int e = 0; e < 4; ++e) acc[b][e] = 0.f;
#pragma unroll 8
        for (int i = 0; i < 32; ++i) {
            const int k = kp + 64 * i;
            const f32x4 wv = *(const f32x4*)(w_ada + (size_t)k * 6144 + 32 * j + 4 * cgp);
#pragma unroll
            for (int b = 0; b < 8; ++b) { const float sv = s[b * 2048 + k];
#pragma unroll
                for (int e = 0; e < 4; ++e) acc[b][e] += sv * wv[e]; }
        }
#pragma unroll
        for (int b = 0; b < 8; ++b)
#pragma unroll
            for (int e = 0; e < 4; ++e) red[kp * 256 + b * 32 + 4 * cgp + e] = acc[b][e];
        __syncthreads();
        if (tid < 256) {
            float sum = 0.f;
            for (int q = 0; q < 64; ++q) sum += red[q * 256 + tid];
            const int b = tid >> 5, col = tid & 31;
            mod[b * 6144 + 32 * j + col] = sum + b_ada[32 * j + col];
        }
        __syncthreads();
    }
    LAS float* scr = (LAS float*)(lds + wave * 16384);
    const int gw = blockIdx.x * NWAVES + wave, NGW = gridDim.x * NWAVES;
    bf16* WinT = (bf16*)(a.ws + WS_WIN); bf16* WoutT = (bf16*)(a.ws + WS_WOUT);
    constexpr int I_IN = (D / 64) * (NIN / 32), I_OUT = (D / 64) * (D / 32);
    for (int it = gw; it < I_IN; it += NGW) p0_transpose_item(a.in[6], D, NIN, WinT, scr, it, lane);
    (void)WoutT; (void)I_OUT;
    { v4u* z = (v4u*)(WinT + (size_t)NIN * D); const int nz = (NP - NIN) * D * 2 / 16;
      for (int i = blockIdx.x * 512 + tid; i < nz; i += gridDim.x * 512) z[i] = (v4u){0u, 0u, 0u, 0u}; }
}

__device__ __forceinline__ void phase1(const Args& a, int wave, int lane) {
    const float* x = a.in[0]; const float* g = a.in[4];
    const float* mod = (const float*)(a.ws + WS_MOD); bf16* H = (bf16*)(a.ws + WS_H);
    const int gw = blockIdx.x * NWAVES + wave, NGW = gridDim.x * NWAVES;
    for (int m = gw; m < M; m += NGW) {
        const int b = m >> 11;
        const f32x4* xr = (const f32x4*)(x + (size_t)m * D) + lane;
        f32x4 v[8]; float ss = 0.f;
#pragma unroll
        for (int j = 0; j < 8; ++j) { v[j] = xr[64 * j]; ss += (v[j].x * v[j].x + v[j].y * v[j].y) + (v[j].z * v[j].z + v[j].w * v[j].w); }
        const float rinv = rsqrtf(wave_sum(ss) * (1.f / D) + 1e-6f);
        v2u* o8 = (v2u*)(H + (size_t)m * D) + lane;
#pragma unroll
        for (int j = 0; j < 8; ++j) {
            const int col = 4 * lane + 256 * j;
            const f32x4 g4 = *(const f32x4*)(g + col);
            const f32x4 sh = *(const f32x4*)(mod + b * 6144 + col);
            const f32x4 sc = *(const f32x4*)(mod + b * 6144 + 2048 + col);
            const f32x4 o = v[j] * rinv * g4 * (sc + 1.f) + sh;
            v2u w; w.x = pk2(o.x, o.y); w.y = pk2(o.z, o.w);
            o8[64 * j] = w;
        }
    }
}

__device__ __forceinline__ void attn_phase(LAS unsigned char* lds, const bf16* P, bf16* mix, const float* sinks, int u0, int ustride, int nunits, int tid, int wave, int lane) {
    constexpr int KP = 72, VP = 264;
    LAS bf16* Ks = (LAS bf16*)lds;
    LAS bf16* Vt = (LAS bf16*)(lds + 36864);
    const int c = lane & 15, hq = lane >> 4, g = wave >> 1, half = wave & 1;
    v4u kv[4], vv[4];
#define A_LOAD(uu) do { const int b_ = (uu) >> 6, n_ = ((uu) >> 2) & 15, hk_ = (uu) & 3; \
        _Pragma("unroll") for (int i = 0; i < 4; ++i) { const int idx = tid + 512 * i, key = idx >> 3, part = idx & 7, tok = (n_ - 1) * 128 + key; \
            kv[i] = (v4u){0u, 0u, 0u, 0u}; vv[i] = (v4u){0u, 0u, 0u, 0u}; \
            if (tok >= 0) { const size_t row = (size_t)(b_ * T + tok) * NP; kv[i] = *(const v4u*)(P + row + C_K + hk_ * 64 + part * 8); vv[i] = *(const v4u*)(P + row + C_V + hk_ * 64 + part * 8); } } } while (0)
    A_LOAD(u0);
    for (int ui = 0; ui < nunits; ++ui) {
        const int u = u0 + ui * ustride, b = u >> 6, n = (u >> 2) & 15, hk = u & 3, head = hk * 4 + g;
#pragma unroll
        for (int i = 0; i < 4; ++i) { const int idx = tid + 512 * i, key = idx >> 3, part = idx & 7;
            *(LAS v4u*)(Ks + key * KP + part * 8) = kv[i];
#pragma unroll
            for (int e = 0; e < 8; ++e) Vt[(part * 8 + e) * VP + key] = (bf16)((vv[i][e >> 1] >> (16 * (e & 1))) & 0xffffu); }
        __syncthreads();
        if (ui + 1 < nunits) A_LOAD(u + ustride);
        const float sink = sinks[head];
        const size_t rowq = (size_t)(b * T + n * 128 + half * 64 + c);
        bf16x8 qf[2], nqf[2]; v2u ga[4], nga[4];
#pragma unroll
        for (int ks = 0; ks < 2; ++ks) qf[ks] = *(const bf16x8*)(P + rowq * NP + C_Q + head * 64 + 32 * ks + 8 * hq);
#pragma unroll
        for (int dt = 0; dt < 4; ++dt) ga[dt] = *(const v2u*)(P + rowq * NP + C_GA + head * 64 + 16 * dt + 4 * hq);
        for (int ch = 0; ch < 4; ++ch) {
            const int q0 = half * 64 + ch * 16, tb = ((q0 >> 4) >> 1) * 2;
            if (ch + 1 < 4) { const size_t rn = (rowq + 16 * (ch + 1)) * NP;
#pragma unroll
                for (int ks = 0; ks < 2; ++ks) nqf[ks] = *(const bf16x8*)(P + rn + C_Q + head * 64 + 32 * ks + 8 * hq);
#pragma unroll
                for (int dt = 0; dt < 4; ++dt) nga[dt] = *(const v2u*)(P + rn + C_GA + head * 64 + 16 * dt + 4 * hq); }
            f32x4 s[10];
#pragma unroll
            for (int tl = 0; tl < 10; ++tl) {
                f32x4 acc = (f32x4){0.f, 0.f, 0.f, 0.f};
#pragma unroll
                for (int ks = 0; ks < 2; ++ks) { const bf16x8 kf = *(const LAS bf16x8*)(Ks + (16 * (tb + tl) + c) * KP + 32 * ks + 8 * hq);
                    acc = __builtin_amdgcn_mfma_f32_16x16x32_bf16(kf, qf[ks], acc, 0, 0, 0); }
                s[tl] = acc;
            }
            const int qi = q0 + c;
            float mx = sink;
#pragma unroll
            for (int tl = 0; tl < 10; ++tl)
#pragma unroll
                for (int r = 0; r < 4; ++r) { const int si = 16 * (tb + tl) + 4 * hq + r;
                    const bool valid = (si > qi) && (si <= qi + 128) && (n > 0 || si >= 128);
                    const float sv = valid ? s[tl][r] * 0.125f : -1e30f; s[tl][r] = sv; mx = fmaxf(mx, sv); }
            mx = fmaxf(mx, __shfl_xor(mx, 16)); mx = fmaxf(mx, __shfl_xor(mx, 32));
            float sum = 0.f;
#pragma unroll
            for (int tl = 0; tl < 10; ++tl)
#pragma unroll
                for (int r = 0; r < 4; ++r) { const float p = __expf(s[tl][r] - mx); s[tl][r] = p; sum += p; }
            sum += __shfl_xor(sum, 16); sum += __shfl_xor(sum, 32);
            const float inv = rcp_f(sum + __expf(sink - mx));
            f32x4 o[4];
#pragma unroll
            for (int dt = 0; dt < 4; ++dt) o[dt] = (f32x4){0.f, 0.f, 0.f, 0.f};
#pragma unroll
            for (int kp = 0; kp < 5; ++kp) {
                v4u pw; pw.x = pk2(s[2 * kp][0], s[2 * kp][1]); pw.y = pk2(s[2 * kp][2], s[2 * kp][3]); pw.z = pk2(s[2 * kp + 1][0], s[2 * kp + 1][1]); pw.w = pk2(s[2 * kp + 1][2], s[2 * kp + 1][3]);
                const bf16x8 pf = __builtin_bit_cast(bf16x8, pw);
#pragma unroll
                for (int dt = 0; dt < 4; ++dt) {
                    const v2u v0 = *(const LAS v2u*)(Vt + (16 * dt + c) * VP + 16 * (tb + 2 * kp) + 4 * hq);
                    const v2u v1 = *(const LAS v2u*)(Vt + (16 * dt + c) * VP + 16 * (tb + 2 * kp + 1) + 4 * hq);
                    v4u vw; vw.x = v0.x; vw.y = v0.y; vw.z = v1.x; vw.w = v1.y;
                    o[dt] = __builtin_amdgcn_mfma_f32_16x16x32_bf16(__builtin_bit_cast(bf16x8, vw), pf, o[dt], 0, 0, 0);
                }
            }
            bf16* orow = mix + (rowq + 16 * ch) * D + head * 64 + 4 * hq;
#pragma unroll
            for (int dt = 0; dt < 4; ++dt) {
                const float g0 = bflo(ga[dt].x), g1 = bfhi(ga[dt].x), g2 = bflo(ga[dt].y), g3 = bfhi(ga[dt].y);
                v2u w; w.x = pk2(o[dt][0] * inv * silu_f(g0), o[dt][1] * inv * silu_f(g1)); w.y = pk2(o[dt][2] * inv * silu_f(g2), o[dt][3] * inv * silu_f(g3));
                *(v2u*)(orow + 16 * dt) = w;
            }
#pragma unroll
            for (int ks = 0; ks < 2; ++ks) qf[ks] = nqf[ks];
#pragma unroll
            for (int dt = 0; dt < 4; ++dt) ga[dt] = nga[dt];
        }
        __syncthreads();
    }
#undef A_LOAD
}

#define XB_TMO      128
#define XB_XCNT(j)  (256  + 64 * (j))
#define XB_XSUB(j)  (1280 + 64 * (j))
#define XB_XGEN(j)  (2304 + 64 * (j))
#define XB_TOP      3328
#define XB_TOPGEN   3392
#define XCD_BAR_WORDS 3456
#define XB_SPIN_CAP (1u << 18)

__device__ __forceinline__ unsigned xb_ld(unsigned* p)              { return __hip_atomic_load(p, __ATOMIC_RELAXED, __HIP_MEMORY_SCOPE_AGENT); }
__device__ __forceinline__ unsigned xb_add(unsigned* p, unsigned v) { return __hip_atomic_fetch_add(p, v, __ATOMIC_RELAXED, __HIP_MEMORY_SCOPE_AGENT); }
__device__ __forceinline__ unsigned xb_xcc_id() { return (unsigned)__builtin_amdgcn_s_getreg((3 << 11) | 20) & 0xFu; }
#define XB_SPIN(cond, bar) do { unsigned _sp = 0; while (cond) { __builtin_amdgcn_s_sleep(1); \
    if ((++_sp & 255u) == 0u) { if (xb_ld(&(bar)[XB_TMO])) break; if (_sp > XB_SPIN_CAP) { atomicAdd(&(bar)[XB_TMO], 1u); break; } } } } while (0)

struct XcdBarrier {
    unsigned* bar; unsigned x;
    volatile LAS unsigned* st;
};

__device__ __forceinline__ XcdBarrier xcd_barrier_post(unsigned* bar, volatile LAS unsigned* st) {
    XcdBarrier b; b.bar = bar; b.x = xb_xcc_id(); b.st = st;
    if (threadIdx.x == 0) (void)xb_add(&bar[XB_XCNT(b.x)], 1u);
    return b;
}
__device__ __forceinline__ void xcd_barrier_complete(unsigned* bar, unsigned x, unsigned& nloc, unsigned& nx) {
    const unsigned G = gridDim.x * gridDim.y * gridDim.z;
    unsigned sum, cnt, mine, sp = 0u;
    for (;;) {
        sum = 0u; cnt = 0u; mine = 0u;
#pragma unroll
        for (unsigned j = 0; j < 16; ++j) { const unsigned c = xb_ld(&bar[XB_XCNT(j)]); sum += c; cnt += (c > 0u) ? 1u : 0u; mine = (j == x) ? c : mine; }
        if (sum == G) break;
        __builtin_amdgcn_s_sleep(1);
        if ((++sp & 255u) == 0u) { if (xb_ld(&bar[XB_TMO])) break; if (sp > XB_SPIN_CAP) { atomicAdd(&bar[XB_TMO], 1u); break; } }
    }
    nloc = mine > 0u ? mine : 1u; nx = cnt > 0u ? cnt : 1u;
}

__device__ __forceinline__ void xcd_barrier(const XcdBarrier& b) {
    asm volatile("s_waitcnt vmcnt(0)" ::: "memory");
    __syncthreads();
    if (threadIdx.x == 0) {
        unsigned* bar = b.bar;
        __builtin_amdgcn_s_waitcnt(0);
        unsigned nloc = b.st[0], nx = b.st[1];
        if (nloc == 0u) { xcd_barrier_complete(bar, b.x, nloc, nx); b.st[0] = nloc; b.st[1] = nx; }
        const unsigned old = xb_add(&bar[XB_XSUB(b.x)], 1u);
        const unsigned gen = old / nloc;
        if (old + 1u == (gen + 1u) * nloc) {
            __builtin_amdgcn_fence(__ATOMIC_RELEASE, "agent");
            asm volatile("s_waitcnt vmcnt(0)" ::: "memory");
            const unsigned og = xb_add(&bar[XB_TOP], 1u);
            const unsigned tg = og / nx;
            if (og + 1u == (tg + 1u) * nx) xb_add(&bar[XB_TOPGEN], 1u);
            else XB_SPIN(xb_ld(&bar[XB_TOPGEN]) == tg, bar);
            __builtin_amdgcn_fence(__ATOMIC_ACQUIRE, "agent");
            xb_add(&bar[XB_XGEN(b.x)], 1u);
            asm volatile("s_waitcnt vmcnt(0)" ::: "memory");
        } else {
            XB_SPIN(xb_ld(&bar[XB_XGEN(b.x)]) == gen, bar);
            __builtin_amdgcn_fence(__ATOMIC_ACQUIRE, "agent");
            asm volatile("s_waitcnt vmcnt(0)" ::: "memory");
        }
    }
    __syncthreads();
}
__device__ __forceinline__ void phase25(const Args& a, int wave, int lane) {
    const bf16* P = (const bf16*)(a.ws + WS_PROJ);
    bf16* XW = (bf16*)(a.ws + WS_XW); bf16* XA = (bf16*)(a.ws + WS_XA); float* RN = (float*)(a.ws + WS_RN);
    const float* mu = a.in[9]; const float* k_k = a.in[14];
    const float mu_w = mu[3072 + lane], mu_a = mu[3136 + lane];
    float muk[16], kkc[16];
#pragma unroll
    for (int j = 0; j < 16; ++j) { muk[j] = mu[1024 + lane * 16 + j]; kkc[j] = k_k[lane * 16 + j]; }
    const int gw = blockIdx.x * NWAVES + wave, NGW = gridDim.x * NWAVES;
    for (int m = gw; m < M; m += NGW) {
        const bool first = (m & (T - 1)) == 0;
        const bf16* pr = P + (size_t)m * NP;
        const float wc = bflo((unsigned)pr[C_WD + lane]), ac = bflo((unsigned)pr[C_AD + lane]);
        const float wp = first ? 0.f : bflo((unsigned)pr[C_WD + lane - NP]), ap = first ? 0.f : bflo((unsigned)pr[C_AD + lane - NP]);
        XW[(size_t)m * 64 + lane] = (bf16)f2bf(tanh_f(wc + (wp - wc) * mu_w));
        XA[(size_t)m * 64 + lane] = (bf16)f2bf(ac + (ap - ac) * mu_a);
        v4u kc[2], kp[2];
#pragma unroll
        for (int h = 0; h < 2; ++h) { kc[h] = *(const v4u*)(pr + C_RK + lane * 16 + 8 * h);
            kp[h] = first ? (v4u){0u, 0u, 0u, 0u} : *(const v4u*)(pr - NP + C_RK + lane * 16 + 8 * h); }
        float ssq = 0.f;
#pragma unroll
        for (int h = 0; h < 2; ++h)
#pragma unroll
            for (int j = 0; j < 4; ++j) {
                const float c0 = bflo(kc[h][j]), c1 = bfhi(kc[h][j]), p0 = bflo(kp[h][j]), p1 = bfhi(kp[h][j]);
                const float k0 = (c0 + (p0 - c0) * muk[8 * h + 2 * j]) * kkc[8 * h + 2 * j], k1 = (c1 + (p1 - c1) * muk[8 * h + 2 * j + 1]) * kkc[8 * h + 2 * j + 1];
                ssq += k0 * k0 + k1 * k1; }
        ssq = dpp_add<0xB1>(ssq); ssq = dpp_add<0x4E>(ssq);
        if ((lane & 3) == 0) RN[(size_t)m * 16 + (lane >> 2)] = rsqrtf(fmaxf(ssq, 1e-24f));
    }
}

constexpr int TC = 16, NCH = T / TC;
constexpr int IMG = 12864, I_PA = 0, I_A2 = 4096, I_V = 8192, I_DE = 12288, I_SC = 12544, I_BON = 12800;
constexpr int STG = 14144, P_SC = 12864, P_BON = 13888;
#define WG_BAR() do { asm volatile("s_waitcnt lgkmcnt(0)" ::: "memory"); __builtin_amdgcn_s_barrier(); asm volatile("" ::: "memory"); } while (0)
__device__ __forceinline__ unsigned char* img_ptr(unsigned char* ws, int chain, int chunk) {
    return chain < 14 ? ws + WS_IMGA + ((size_t)chain * NCH + chunk) * IMG : ws + WS_IMGB + ((size_t)(chain - 14) * NCH + chunk) * IMG;
}

__device__ __forceinline__ void rwkv_prepass(LAS unsigned char* lds, const Args& a, int tid, int wave, int lane, int cb, int nch, int G, int bidx) {
    const bf16* P = (const bf16*)(a.ws + WS_PROJ);
    const bf16* XW = (const bf16*)(a.ws + WS_XW); const bf16* XA = (const bf16*)(a.ws + WS_XA); const float* RN = (const float*)(a.ws + WS_RN);
    const int g = wave >> 2, hw = wave & 3, grp = bidx * 2 + g, gpc = G >> 6, ntask = nch / gpc, chain = grp / gpc, c0 = cb + (grp % gpc) * ntask;
    const int b = chain >> 4; const unsigned hh = chain & 15, rowbase = (unsigned)b * T;
    const unsigned cc = lane & 15, hq = lane >> 4; const int ch = 16 * hw + (int)cc; const unsigned col = hh * 64 + ch; const int tg = tid & 255;
    const float* mu = a.in[9];
    const float cw0 = a.in[10][col], ca0 = a.in[12][col], ckk = a.in[14][col], cka = a.in[15][col], crk = a.in[16][col];
    const float mur = mu[col], muk = mu[1024 + col], muv = mu[2048 + col];
    bf16x8 bwf[2], baf[2];
#pragma unroll
    for (int ks = 0; ks < 2; ++ks) {
        float tw[8], ta[8];
#pragma unroll
        for (int j = 0; j < 8; ++j) { const size_t o = (size_t)(32 * ks + 8 * hq + j) * 1024 + col; tw[j] = a.in[11][o]; ta[j] = a.in[13][o]; }
        v4u w; w.x = pk2(tw[0], tw[1]); w.y = pk2(tw[2], tw[3]); w.z = pk2(tw[4], tw[5]); w.w = pk2(tw[6], tw[7]); bwf[ks] = __builtin_bit_cast(bf16x8, w);
        v4u v; v.x = pk2(ta[0], ta[1]); v.y = pk2(ta[2], ta[3]); v.z = pk2(ta[4], ta[5]); v.w = pk2(ta[6], ta[7]); baf[ks] = __builtin_bit_cast(bf16x8, v);
    }
    const int pa_w = (hw >> 1) * 256 + (cc >> 2) * 16 + ((hw & 1) * 4 + (cc & 3)) * 2;
    v4u n_aw[2], n_aa[2], c_aw[2], c_aa[2], m_aw[2], m_aa[2];
    unsigned n_rc[4], n_kc[4], n_vc[4], n_rp, n_kp, n_vp, c_rc[4], c_kc[4], c_vc[4], c_rp, c_kp, c_vp, m_rc[4], m_kc[4], m_vc[4], m_rp, m_kp, m_vp;
    float n_rn[4], c_rn[4], m_rn[4];
#define H_LOAD(k) do { const unsigned t0_ = (unsigned)(k) * TC; const unsigned ra_ = (rowbase + t0_ + cc) * 64u + 8u * hq; \
        _Pragma("unroll") for (int ks = 0; ks < 2; ++ks) { n_aw[ks] = *(const v4u*)(XW + (ra_ + 32u * ks)); n_aa[ks] = *(const v4u*)(XA + (ra_ + 32u * ks)); } \
        const unsigned tb_ = t0_ + 4u * hq, pe_ = (rowbase + tb_) * (unsigned)NP + col; \
        _Pragma("unroll") for (int r = 0; r < 4; ++r) { n_rc[r] = P[pe_ + (unsigned)(r * NP + C_R)]; n_kc[r] = P[pe_ + (unsigned)(r * NP + C_RK)]; n_vc[r] = P[pe_ + (unsigned)(r * NP + C_RV)]; \
            n_rn[r] = RN[(rowbase + tb_ + r) * 16u + hh]; } \
        if (tb_ > 0u) { n_rp = P[pe_ - (unsigned)(NP - C_R)]; n_kp = P[pe_ - (unsigned)(NP - C_RK)]; n_vp = P[pe_ - (unsigned)(NP - C_RV)]; } else { n_rp = 0u; n_kp = 0u; n_vp = 0u; } \
    } while (0)
#define H_ADV() do { _Pragma("unroll") for (int ks = 0; ks < 2; ++ks) { c_aw[ks] = m_aw[ks]; c_aa[ks] = m_aa[ks]; m_aw[ks] = n_aw[ks]; m_aa[ks] = n_aa[ks]; } \
        _Pragma("unroll") for (int r = 0; r < 4; ++r) { c_rc[r] = m_rc[r]; c_kc[r] = m_kc[r]; c_vc[r] = m_vc[r]; c_rn[r] = m_rn[r]; m_rc[r] = n_rc[r]; m_kc[r] = n_kc[r]; m_vc[r] = n_vc[r]; m_rn[r] = n_rn[r]; } \
        c_rp = m_rp; c_kp = m_kp; c_vp = m_vp; m_rp = n_rp; m_kp = n_kp; m_vp = n_vp; } while (0)
    H_LOAD(c0); H_ADV(); H_LOAD(c0 + 1);
    for (int k = 0; k < ntask; ++k) {
        LAS unsigned char* B_ = lds + (g * 2 + (k & 1)) * STG;
        H_ADV();
        if (k + 2 < ntask) H_LOAD(c0 + k + 2);
        f32x4 accw = (f32x4){0.f, 0.f, 0.f, 0.f}, acca = (f32x4){0.f, 0.f, 0.f, 0.f};
#pragma unroll
        for (int ks = 0; ks < 2; ++ks) { accw = __builtin_amdgcn_mfma_f32_16x16x32_bf16(__builtin_bit_cast(bf16x8, c_aw[ks]), bwf[ks], accw, 0, 0, 0);
            acca = __builtin_amdgcn_mfma_f32_16x16x32_bf16(__builtin_bit_cast(bf16x8, c_aa[ks]), baf[ks], acca, 0, 0, 0); }
        float dec_[4], rr_[4], vx_[4], kkn_[4], k2_[4], bv_[4], pbo_[4], psc_[2][8];
#pragma unroll
        for (int r = 0; r < 4; ++r) {
            const float rcu = bflo(c_rc[r]), kcu = bflo(c_kc[r]), vcu = bflo(c_vc[r]);
            const float rpv = bflo(r == 0 ? c_rp : c_rc[r > 0 ? r - 1 : 0]), kpv = bflo(r == 0 ? c_kp : c_kc[r > 0 ? r - 1 : 0]), vpv = bflo(r == 0 ? c_vp : c_vc[r > 0 ? r - 1 : 0]);
            const float rr = rcu + (rpv - rcu) * mur, kx = kcu + (kpv - kcu) * muk; vx_[r] = vcu + (vpv - vcu) * muv;
            dec_[r] = __expf(-0.60653066f * rcp_f(1.f + __expf(-(cw0 + accw[r]))));
            const float ic = rcp_f(1.f + __expf(-(ca0 + acca[r])));
            const float kkn = kx * ckk * c_rn[r], k2 = kx * (1.f + (ic - 1.f) * cka), bv = kkn * ic;
            rr_[r] = rr; kkn_[r] = kkn; k2_[r] = k2; bv_[r] = bv;
            pbo_[r] = reduce16(rr * k2 * crk); }
#pragma unroll
        for (int pl = 0; pl < 2; ++pl) { const int r0 = 2 * pl, r1 = r0 + 1; const float wr1 = dec_[r1] * rr_[r1];
            psc_[pl][0] = reduce16(bv_[r0] * rr_[r0]); psc_[pl][1] = reduce16(k2_[r0] * rr_[r0]);
            psc_[pl][2] = reduce16(-bv_[r0] * kkn_[r1]); psc_[pl][3] = reduce16(-k2_[r0] * kkn_[r1]);
            psc_[pl][4] = reduce16(bv_[r0] * wr1); psc_[pl][5] = reduce16(k2_[r0] * wr1);
            psc_[pl][6] = reduce16(bv_[r1] * rr_[r1]); psc_[pl][7] = reduce16(k2_[r1] * rr_[r1]); }
        if (cc == 0) {
#pragma unroll
            for (int r = 0; r < 4; ++r) *(LAS float*)(B_ + P_BON + ((4 * hq + r) * 4 + hw) * 4) = pbo_[r];
#pragma unroll
            for (int pl = 0; pl < 2; ++pl)
#pragma unroll
                for (int e = 0; e < 8; ++e) *(LAS float*)(B_ + P_SC + (((2 * hq + pl) * 8 + e) * 4 + hw) * 4) = psc_[pl][e]; }
        { float D_[4], Dp_[4]; const float p0 = dec_[0], p1 = p0 * dec_[1], p2 = p1 * dec_[2], p3 = p2 * dec_[3];
          const float g0 = __shfl(p3, cc), g1 = __shfl(p3, cc + 16), g2 = __shfl(p3, cc + 32);
          const float E_ = hq == 0 ? 1.f : (hq == 1 ? g0 : (hq == 2 ? g0 * g1 : g0 * g1 * g2));
          D_[0] = E_ * p0; D_[1] = E_ * p1; D_[2] = E_ * p2; D_[3] = E_ * p3; Dp_[0] = E_; Dp_[1] = D_[0]; Dp_[2] = D_[1]; Dp_[3] = D_[2];
#pragma unroll
          for (int r = 0; r < 4; ++r) { const int pr_ = 2 * hq + (r >> 1), od = r & 1; const float rcp = rcp_f(D_[r]);
            const unsigned pw_ = pk2(-kkn_[r] * Dp_[r], D_[r] * rr_[r]);
            *(LAS bf16*)(B_ + I_PA + pr_ * 512 + od * 128 + pa_w) = (bf16)(pw_ & 0xffffu); *(LAS bf16*)(B_ + I_PA + pr_ * 512 + od * 128 + 64 + pa_w) = (bf16)(pw_ >> 16);
            *(LAS unsigned*)(B_ + I_A2 + (pr_ * 64 + ch) * 8 + od * 4) = pk2(bv_[r] * rcp, k2_[r] * rcp); *(LAS float*)(B_ + I_V + (pr_ * 64 + ch) * 8 + od * 4) = vx_[r]; }
          if (hq == 3) *(LAS float*)(B_ + I_DE + ch * 4) = D_[3]; }
        WG_BAR();
        unsigned char* gi = img_ptr(a.ws, chain, c0 + k);
#pragma unroll
        for (int i = 0; i < 3; ++i) *(v4u*)(gi + (tg + 256 * i) * 16) = *(const LAS v4u*)(B_ + (tg + 256 * i) * 16);
        if (tg < 16) *(v4u*)(gi + I_DE + tg * 16) = *(const LAS v4u*)(B_ + I_DE + tg * 16);
        else if (tg < 36) { const int j_ = tg - 16;
            const LAS unsigned char* pp_ = B_ + (j_ < 16 ? P_SC + j_ * 64 : P_BON + (j_ - 16) * 64);
            f32x4 o_;
#pragma unroll
            for (int e = 0; e < 4; ++e) { const f32x4 q_ = *(const LAS f32x4*)(pp_ + e * 16); o_[e] = (q_[0] + q_[1]) + (q_[2] + q_[3]); }
            *(f32x4*)(gi + (j_ < 16 ? I_SC + j_ * 16 : I_BON + (j_ - 16) * 16)) = o_; }
    }
    WG_BAR();
#undef H_LOAD
#undef H_ADV
}

constexpr int O_Y = 3 * IMG;
__device__ __forceinline__ void rwkv_block(LAS unsigned char* lds, const Args& a, int chain, int cbeg, int cend, f32x4 (&st)[4], int tid, int wave, int lane) {
    const int b = chain >> 4, hh = chain & 15, rowbase = b * T;
    if (wave < 4) {
        const int i = lane & 15, hq = lane >> 4, n = 16 * wave + i;
        const unsigned hmask = hq == 0 ? 0xffffffffu : 0u;
        const int pa_off = (i & 3) * 64 + hq * 16;
        const f32x4 zero4 = (f32x4){0.f, 0.f, 0.f, 0.f};
        WG_BAR();
        __builtin_amdgcn_s_setprio(3);
        int bi = 0;
        for (int c = cbeg; c < cend; ++c) {
            LAS unsigned char* B = lds + bi * IMG;
            LAS unsigned char* Yb = lds + O_Y + (c & 1) * 4096;
            const float scv = *(const LAS float*)(B + I_SC + lane * 4);
            bf16x8 pa0 = *(const LAS bf16x8*)(B + I_PA + pa_off), pa1 = *(const LAS bf16x8*)(B + I_PA + 256 + pa_off);
            f32x2 v2 = *(const LAS f32x2*)(B + I_V + n * 8);
            v2u a2[4];
#pragma unroll
            for (int q = 0; q < 4; ++q) a2[q] = *(const LAS v2u*)(B + I_A2 + (16 * q + i) * 8);
#pragma unroll
            for (int pp = 0; pp < TC / 2; ++pp) {
                bf16x8 npa0 = pa0, npa1 = pa1; f32x2 nv2 = v2; v2u na2[4];
#pragma unroll
                for (int q = 0; q < 4; ++q) na2[q] = a2[q];
                if (pp + 1 < TC / 2) {
                    npa0 = *(const LAS bf16x8*)(B + I_PA + ((pp + 1) * 2 + 0) * 256 + pa_off); npa1 = *(const LAS bf16x8*)(B + I_PA + ((pp + 1) * 2 + 1) * 256 + pa_off);
                    nv2 = *(const LAS f32x2*)(B + I_V + ((pp + 1) * 64 + n) * 8);
#pragma unroll
                    for (int q = 0; q < 4; ++q) na2[q] = *(const LAS v2u*)(B + I_A2 + ((pp + 1) * 64 + 16 * q + i) * 8);
                }
                __builtin_amdgcn_sched_barrier(0);
                v4u s0, s1;
                s0.x = pk2(st[0][0], st[0][1]); s0.y = pk2(st[0][2], st[0][3]); s0.z = pk2(st[1][0], st[1][1]); s0.w = pk2(st[1][2], st[1][3]);
                s1.x = pk2(st[2][0], st[2][1]); s1.y = pk2(st[2][2], st[2][3]); s1.z = pk2(st[3][0], st[3][1]); s1.w = pk2(st[3][2], st[3][3]);
                const f32x4 d0 = __builtin_amdgcn_mfma_f32_16x16x32_bf16(pa0, __builtin_bit_cast(bf16x8, s0), zero4, 0, 0, 0);
                const f32x4 d1 = __builtin_amdgcn_mfma_f32_16x16x32_bf16(pa1, __builtin_bit_cast(bf16x8, s1), zero4, 0, 0, 0);
                const f32x4 d = d0 + d1;
                float sc[8];
#pragma unroll
                for (int e = 0; e < 8; ++e) sc[e] = __builtin_bit_cast(float, __builtin_amdgcn_readlane(__builtin_bit_cast(int, scv), pp * 8 + e));
                const float sa0 = d[0];
                const float sa1 = d[2] + sa0 * sc[2] + v2[0] * sc[3];
                *(LAS float*)(Yb + ((2 * pp) * 64 + n) * 4) = d[1] + sa0 * sc[0] + v2[0] * sc[1];
                *(LAS float*)(Yb + ((2 * pp + 1) * 64 + n) * 4) = (d[3] + sa0 * sc[4] + v2[0] * sc[5]) + (sa1 * sc[6] + v2[1] * sc[7]);
                v2u bw; bw.x = pk2(sa0, v2[0]) & hmask; bw.y = pk2(sa1, v2[1]) & hmask;
                const s16x4 bfr = __builtin_bit_cast(s16x4, bw);
#pragma unroll
                for (int q = 0; q < 4; ++q) st[q] = __builtin_amdgcn_mfma_f32_16x16x16bf16_1k(__builtin_bit_cast(s16x4, a2[q]), bfr, st[q], 0, 0, 0);
                pa0 = npa0; pa1 = npa1; v2 = nv2;
#pragma unroll
                for (int q = 0; q < 4; ++q) a2[q] = na2[q];
            }
#pragma unroll
            for (int q = 0; q < 4; ++q) st[q] = st[q] * *(const LAS f32x4*)(B + I_DE + (16 * q + 4 * hq) * 4);
            bi = bi == 2 ? 0 : bi + 1;
            WG_BAR();
        }
        __builtin_amdgcn_s_setprio(0);
    } else {
        const bf16* P = (const bf16*)(a.ws + WS_PROJ); bf16* mix = (bf16*)(a.ws + WS_H);
        const int hw = wave - 4, cc = lane & 15, hq = lane >> 4, ch = 16 * hw + cc, col = hh * 64 + ch, tg = tid - 256;
        const float clw = a.in[17][col], clb = a.in[18][col];
        const unsigned char* ibase = img_ptr(a.ws, chain, 0);
        const bf16x8 ones8 = __builtin_bit_cast(bf16x8, (v4u){0x3f803f80u, 0x3f803f80u, 0x3f803f80u, 0x3f803f80u});
        v4u imA[3], itA = (v4u){0u, 0u, 0u, 0u}, imB[3], itB = (v4u){0u, 0u, 0u, 0u}; unsigned gE[4] = {0u, 0u, 0u, 0u}, gO[4] = {0u, 0u, 0u, 0u};
#define I_LOAD(im, it, k) do { const unsigned go_ = (unsigned)((k) * IMG); \
        _Pragma("unroll") for (int i_ = 0; i_ < 3; ++i_) im[i_] = *(const v4u*)(ibase + (go_ + (unsigned)((tg + 256 * i_) * 16))); \
        if (tg < 36) it = *(const v4u*)(ibase + (go_ + (unsigned)(I_DE + tg * 16))); } while (0)
#define I_STORE(im, it, bix) do { LAS unsigned char* B_ = lds + (bix) * IMG; \
        _Pragma("unroll") for (int i_ = 0; i_ < 3; ++i_) *(LAS v4u*)(B_ + (tg + 256 * i_) * 16) = im[i_]; \
        if (tg < 36) *(LAS v4u*)(B_ + I_DE + tg * 16) = it; } while (0)
#define H_GLOAD(gx, k) do { const unsigned pg_ = (unsigned)((rowbase + (k) * TC + 4 * hq) * NP + C_GR + col); \
        _Pragma("unroll") for (int r = 0; r < 4; ++r) gx[r] = P[pg_ + (unsigned)(r * NP)]; } while (0)
#define H_POST(gx, k, bix) do { LAS unsigned char* B_ = lds + (bix) * IMG; LAS unsigned char* Y_ = lds + O_Y + ((k) & 1) * 4096; \
          \
        f32x4 s1_ = (f32x4){0.f, 0.f, 0.f, 0.f}, s2_ = (f32x4){0.f, 0.f, 0.f, 0.f}; \
        _Pragma("unroll") for (int kb = 0; kb < 2; ++kb) { \
            const f32x4 ya = *(const LAS f32x4*)(Y_ + (cc * 64 + 32 * kb + 8 * hq) * 4), yb = *(const LAS f32x4*)(Y_ + (cc * 64 + 32 * kb + 8 * hq + 4) * 4); \
            v4u f1, f2; f1.x = pk2(ya[0], ya[1]); f1.y = pk2(ya[2], ya[3]); f1.z = pk2(yb[0], yb[1]); f1.w = pk2(yb[2], yb[3]); \
            f2.x = pk2(ya[0] * ya[0], ya[1] * ya[1]); f2.y = pk2(ya[2] * ya[2], ya[3] * ya[3]); f2.z = pk2(yb[0] * yb[0], yb[1] * yb[1]); f2.w = pk2(yb[2] * yb[2], yb[3] * yb[3]); \
            s1_ = __builtin_amdgcn_mfma_f32_16x16x32_bf16(__builtin_bit_cast(bf16x8, f1), ones8, s1_, 0, 0, 0); \
            s2_ = __builtin_amdgcn_mfma_f32_16x16x32_bf16(__builtin_bit_cast(bf16x8, f2), ones8, s2_, 0, 0, 0); } \
        _Pragma("unroll") for (int r = 0; r < 4; ++r) { const int t_ = 4 * hq + r; \
            const float yo = *(const LAS float*)(Y_ + (t_ * 64 + ch) * 4), vv = *(const LAS float*)(B_ + I_V + ((t_ >> 1) * 64 + ch) * 8 + (t_ & 1) * 4), bon = *(const LAS float*)(B_ + I_BON + t_ * 4); \
            const float mean = s1_[r] * (1.f / 64.f), var = fmaxf(s2_[r] * (1.f / 64.f) - mean * mean, 0.f), rs = rsqrtf(var + 64e-5f); \
            const float o_ = ((yo - mean) * rs * clw + clb + bon * vv) * silu_f(bflo(gx[r])); \
            mix[(unsigned)((rowbase + (k) * TC + t_) * D + 1024 + col)] = (bf16)(pk2(o_, o_) & 0xffffu); } \
    } while (0)
        I_LOAD(imA, itA, cbeg); I_STORE(imA, itA, 0);
        I_LOAD(imA, itA, cbeg + 1); I_LOAD(imB, itB, cbeg + 2);
        H_GLOAD(gE, cbeg);
        WG_BAR();
        int bi = 0;
        for (int c = cbeg; c < cend; c += 2) {
            {
                const int bn = bi == 2 ? 0 : bi + 1, bp = bi == 0 ? 2 : bi - 1;
                I_STORE(imA, itA, bn); if (c + 3 < cend) I_LOAD(imA, itA, c + 3);
                if (c > cbeg) H_POST(gO, c - 1, bp);
                H_GLOAD(gO, c + 1);
                bi = bn;
                WG_BAR();
            }
            {
                const int bn = bi == 2 ? 0 : bi + 1, bp = bi == 0 ? 2 : bi - 1;
                if (c + 2 < cend) { I_STORE(imB, itB, bn); if (c + 4 < cend) I_LOAD(imB, itB, c + 4); }
                H_POST(gE, c, bp);
                if (c + 2 < cend) H_GLOAD(gE, c + 2);
                bi = bn;
                WG_BAR();
            }
        }
        H_POST(gO, cend - 1, (bi == 0 ? 2 : bi - 1));
#undef I_LOAD
#undef I_STORE
#undef H_GLOAD
#undef H_POST
    }
    WG_BAR();
}

__device__ __forceinline__ void phase5(const Args& a, int wave, int lane) {
    const float* x = a.in[0]; const float* g = a.in[5];
    const float* mod = (const float*)(a.ws + WS_MOD); const bf16* MO = (const bf16*)(a.ws + WS_MIXOUT);
    const int gw = blockIdx.x * NWAVES + wave, NGW = gridDim.x * NWAVES;
    for (int m = gw; m < M; m += NGW) {
        const int b = m >> 11;
        const v4u* mr = (const v4u*)(MO + (size_t)m * D) + lane;
        const f32x4* xr = (const f32x4*)(x + (size_t)m * D);
        v4u mv[4]; f32x4 xv[8]; float ss = 0.f;
#pragma unroll
        for (int j = 0; j < 4; ++j) mv[j] = mr[64 * j];
#pragma unroll
        for (int j = 0; j < 4; ++j) { xv[2 * j] = xr[128 * j + 2 * lane]; xv[2 * j + 1] = xr[128 * j + 2 * lane + 1]; }
#pragma unroll
        for (int j = 0; j < 4; ++j)
#pragma unroll
            for (int e = 0; e < 4; ++e) { const float lo = bflo(mv[j][e]), hi = bfhi(mv[j][e]); ss += lo * lo + hi * hi; }
        const float rinv = rsqrtf(wave_sum(ss) * (1.f / D) + 1e-6f);
        f32x4* orow = (f32x4*)(a.out + (size_t)m * D);
#pragma unroll
        for (int j = 0; j < 4; ++j)
#pragma unroll
            for (int h = 0; h < 2; ++h) {
                const int col = 512 * j + 8 * lane + 4 * h;
                const f32x4 g4 = *(const f32x4*)(g + col);
                const f32x4 gt = *(const f32x4*)(mod + b * 6144 + 4096 + col);
                const f32x4 v = (f32x4){bflo(mv[j][2 * h]), bfhi(mv[j][2 * h]), bflo(mv[j][2 * h + 1]), bfhi(mv[j][2 * h + 1])};
                orow[128 * j + 2 * lane + h] = xv[2 * j + h] + gt * (v * rinv * g4);
            }
    }
}

__device__ __forceinline__ void sub_barrier(unsigned* cnt, unsigned expect) {
    asm volatile("s_waitcnt vmcnt(0)" ::: "memory");
    __syncthreads();
    if (threadIdx.x == 0) {
        __builtin_amdgcn_fence(__ATOMIC_RELEASE, "agent");
        asm volatile("s_waitcnt vmcnt(0)" ::: "memory");
        __hip_atomic_fetch_add(cnt, 1u, __ATOMIC_RELAXED, __HIP_MEMORY_SCOPE_AGENT);
        unsigned sp = 0;
        while (__hip_atomic_load(cnt, __ATOMIC_RELAXED, __HIP_MEMORY_SCOPE_AGENT) < expect) { __builtin_amdgcn_s_sleep(2); if (++sp > (1u << 22)) break; }
        __builtin_amdgcn_fence(__ATOMIC_ACQUIRE, "agent");
        asm volatile("s_waitcnt vmcnt(0)" ::: "memory");
    }
    __syncthreads();
}

__global__ void __launch_bounds__(NWAVES * 64, 2) hymba_fwd(Args a) {
    extern __shared__ __attribute__((aligned(16))) unsigned char lds_raw[];
    LAS unsigned char* lds = (LAS unsigned char*)lds_raw;
    cg::grid_group grid = cg::this_grid();
    volatile LAS unsigned* xst = (volatile LAS unsigned*)(lds + 131072 + 512);
    if (threadIdx.x < 2) xst[threadIdx.x] = 0u;
    __syncthreads();
    const XcdBarrier xbar = xcd_barrier_post((unsigned*)(a.ws + WS_CTL), xst);
#define GRID_SYNC_CG() do { asm volatile("s_waitcnt vmcnt(0)" ::: "memory"); grid.sync(); } while (0)
#define GRID_SYNC() xcd_barrier(xbar)
    const int tid = threadIdx.x, lane = tid & 63, wave = __builtin_amdgcn_readfirstlane(tid >> 6);

    if (a.out == nullptr) GRID_SYNC_CG();
    phase0(lds, a, tid, wave, lane);
    GRID_SYNC();
    phase1(a, wave, lane);
    GRID_SYNC();
    {
        pg8::Gemm g{(const pg8::bf16_t*)(a.ws + WS_H), (const pg8::bf16_t*)(a.ws + WS_WIN), M, NP, D};
        pg8::StaticOrder S; S.init(M, NP, (int)gridDim.x, (int)blockIdx.x);
        pg8::EpiBf16<0> E{(pg8::bf16_t*)(a.ws + WS_PROJ), NP, nullptr, 0, 0, 1.f};
        pg8::gemm_phase<pg8::EpiBf16<0>, pg8::StaticOrder, true, true>(lds, g, S, E);
    }
    if (blockIdx.x >= 192) {
        LAS float* scr = (LAS float*)(lds + wave * 16384);
        constexpr int I_OUT2 = (D / 64) * (D / 32);
        for (int it = ((int)blockIdx.x - 192) * NWAVES + wave; it < I_OUT2; it += 64 * NWAVES) p0_transpose_item(a.in[7], D, D, (bf16*)(a.ws + WS_WOUT), scr, it, lane);
    }
    GRID_SYNC();
    phase25(a, wave, lane);
    GRID_SYNC();
    rwkv_prepass(lds, a, tid, wave, lane, 0, 64, 256, (int)blockIdx.x);
    GRID_SYNC();
    if (blockIdx.x < 128) {
        f32x4 st[4];
#pragma unroll
        for (int q = 0; q < 4; ++q) st[q] = (f32x4){0.f, 0.f, 0.f, 0.f};
#pragma unroll
        for (int sp = 0; sp < 2; ++sp) {
            int bxo = (int)blockIdx.x; asm volatile("" : "+s"(bxo));
            rwkv_block(lds, a, bxo, 64 * sp, 64 * sp + 64, st, tid, wave, lane);
            GRID_SYNC();
        }
    } else {
        const bf16* P = (const bf16*)(a.ws + WS_PROJ); bf16* mix = (bf16*)(a.ws + WS_H);
        {   int bxo = (int)blockIdx.x - 128; asm volatile("" : "+s"(bxo));
            rwkv_prepass(lds, a, tid, wave, lane, 64, 64, 128, bxo);
            GRID_SYNC(); }
        {   int bxo = (int)blockIdx.x - 128; asm volatile("" : "+s"(bxo));
            attn_phase(lds, P, mix, a.in[8], bxo, 128, 4, tid, wave, lane);
            GRID_SYNC(); }
    }
    {
        pg8::Gemm g{(const pg8::bf16_t*)(a.ws + WS_H), (const pg8::bf16_t*)(a.ws + WS_WOUT), M, D, D};
        pg8::StaticOrder S; S.init(M, D, (int)gridDim.x, (int)blockIdx.x);
        pg8::EpiBf16<0> E{(pg8::bf16_t*)(a.ws + WS_MIXOUT), D, nullptr, 0, 0, 1.f};
        pg8::gemm_phase<pg8::EpiBf16<0>, pg8::StaticOrder, true, true>(lds, g, S, E);
    }
    GRID_SYNC();
    phase5(a, wave, lane);
}

extern "C" void kernel_launch(void* const* d_in, const int* in_sizes, int n_in, void* d_out, int out_size, void* d_ws, size_t ws_size, hipStream_t stream) {
    static int grid = 0;
    if (grid == 0) {
        if (n_in != 19 || out_size != M * D || ws_size < WS_END) { fprintf(stderr, "kernel_launch: unexpected shapes (n_in %d out %d ws %zu)\n", n_in, out_size, ws_size); grid = -1; return; }
        int dev = 0, cus = 0, per_cu = 0;
        (void)hipGetDevice(&dev); (void)hipDeviceGetAttribute(&cus, hipDeviceAttributeMultiprocessorCount, dev);
        (void)hipFuncSetAttribute((const void*)hymba_fwd, hipFuncAttributeMaxDynamicSharedMemorySize, LDS_BYTES);
        (void)hipOccupancyMaxActiveBlocksPerMultiprocessor(&per_cu, (const void*)hymba_fwd, NWAVES * 64, LDS_BYTES);
        (void)hipGetLastError();
        grid = cus > 0 ? cus : 256;
        if (per_cu < 1) fprintf(stderr, "kernel_launch: occupancy query says %d blocks per CU\n", per_cu);
    }
    if (grid < 0) return;
    if (hipMemsetAsync((char*)d_ws + WS_CTL, 0, CTL_BYTES, stream) != hipSuccess) { fprintf(stderr, "kernel_launch: memset of the barrier words failed\n"); return; }
    Args a{};
    for (int i = 0; i < 19; ++i) a.in[i] = (const float*)d_in[i];
    a.out = (float*)d_out; a.ws = (unsigned char*)d_ws;
    void* args[] = {&a};
    hipError_t e = hipLaunchCooperativeKernel((const void*)hymba_fwd, dim3(grid), dim3(NWAVES * 64), args, LDS_BYTES, stream);
    if (e != hipSuccess) fprintf(stderr, "cooperative launch failed: %s (grid %d)\n", hipGetErrorString(e), grid);
}
```

```cpp
#include <hip/hip_runtime.h>
#include <hip/hip_cooperative_groups.h>
#include <cstdio>
#include <cstdint>
namespace cg = cooperative_groups;
namespace pg8 {
#define PG8_LAS __attribute__((address_space(3)))
typedef unsigned short bf16_t;
typedef short bf16x8 __attribute__((ext_vector_type(8)));
typedef float f32x4 __attribute__((ext_vector_type(4)));
typedef unsigned u32x4 __attribute__((ext_vector_type(4)));
constexpr int BM = 256, BK = 64, HALF = 128, HTB = HALF * BK * 2  , STAGE_BYTES = 8 * HTB, NXCD = 8, WGM = 8;

__host__ __device__ __forceinline__ int lds_byte(int r, int c) { const int st = (r >> 4) * 2 + (c >> 5), rr = r & 15, cc = c & 31, ob = rr * 64 + cc * 2; return st * 1024 + (ob ^ (((ob >> 9) & 1) << 5)); }
__host__ __device__ __forceinline__ void stage_rc(int b, int& R, int& C) { const int st = b / 1024, sb = b % 1024, swz = sb ^ (((sb >> 9) & 1) << 5); R = (st >> 1) * 16 + swz / 64; C = (st & 1) * 32 + (swz % 64) / 2; }
__host__ __device__ __forceinline__ int perm32(int rho) { const int n = rho >> 4, i = rho & 15; return 8 * (i >> 2) + 4 * n + (i & 3); }

struct Unit { int pm, pn; };
struct Gemm { const bf16_t* A; const bf16_t* Bt; int M, N, K; };

struct StaticOrder {
    int nM, nN, nwg, G, c;
    __host__ __device__ void init(int M, int N, int G_, int c_) { nM = M / BM; nN = N / BM; nwg = nM * nN; G = G_; c = c_; }
    __host__ __device__ bool next(int i, Unit& u) const {
        const long L = (long)i * G + c; if (L >= nwg) return false;
        int wgid = (int)L; { const int q = nwg / NXCD, r = nwg % NXCD, xcd = wgid % NXCD, off = wgid / NXCD; wgid = (xcd < r ? xcd * (q + 1) : r * (q + 1) + (xcd - r) * q) + off; }
        const int nig = WGM * nN, gid = wgid / nig, fm = gid * WGM, gsz = (nM - fm) < WGM ? (nM - fm) : WGM;
        u.pm = fm + ((wgid % nig) % gsz); u.pn = (wgid % nig) / gsz; return true;
    }
    __device__ __forceinline__ void a_ready(const Unit&) const {}
    __device__ __forceinline__ void done(const Unit&) const {}
};

typedef __bf16 bf16x2n_t __attribute__((ext_vector_type(2))); typedef float f32x2n_t __attribute__((ext_vector_type(2)));
__device__ __forceinline__ unsigned cvt_pk_bf16(float lo, float hi) { const f32x2n_t v = {lo, hi}; return __builtin_bit_cast(unsigned, __builtin_convertvector(v, bf16x2n_t)); }
typedef float f32x2 __attribute__((ext_vector_type(2)));
__device__ __forceinline__ f32x2 gelu_pk(f32x2 v) {
    const f32x2 av = __builtin_elementwise_abs(v), d = av * 0.2316418882f + 1.0f;
    f32x2 t; t.x = __builtin_amdgcn_rcpf(d.x); t.y = __builtin_amdgcn_rcpf(d.y);
    f32x2 q = t * 0.5307027145f + (-0.7265760135f); q = q * t + 0.7107068705f; q = q * t + (-0.142248368f); q = q * t + 0.127414796f; q = q * t;
    const f32x2 s = (v * v) * (-0.72134752044f);
    f32x2 e; e.x = __builtin_amdgcn_exp2f(s.x); e.y = __builtin_amdgcn_exp2f(s.y);
    const f32x2 m = v * (q * e), r = v - m;
    f32x2 o; o.x = v.x < 0.f ? m.x : r.x; o.y = v.y < 0.f ? m.y : r.y; return o;
}

template <int ACT  > struct EpiBf16 {
    static constexpr bool PERM = true, AFTER_DRAIN = false; static_assert(ACT == 0 || ACT == 1, "EpiBf16: ACT is 0 (none) or 1 (gelu_pk)");
    bf16_t* O; int ldc; const float* bias; int split_cols; size_t split_stride; float scale0;
    __device__ __forceinline__ void operator()(const f32x4 (&acc)[2][2][4][2], const Unit& u, int wr, int wc, int fr, int fq) const {
        const int row0 = u.pm * BM + wr * 64 + fr; int colt = u.pn * BM; bf16_t* base = O;
        float sc = 1.f; if (split_cols) { const int t = colt / split_cols; base += (size_t)t * split_stride; colt -= t * split_cols; if (t == 0) sc = scale0; }
        const int col0 = colt + wc * 32 + 8 * fq, bcol0 = u.pn * BM + wc * 32 + 8 * fq;
        f32x4 bv[2][2];
#pragma unroll
        for (int bj = 0; bj < 2; ++bj)
#pragma unroll
            for (int n = 0; n < 2; ++n) bv[bj][n] = bias ? *(const f32x4*)(bias + bcol0 + bj * HALF + 4 * n) : (f32x4){0.f, 0.f, 0.f, 0.f};
#pragma unroll
        for (int ai = 0; ai < 2; ++ai)
#pragma unroll
            for (int m = 0; m < 4; ++m) { bf16_t* rowp = base + (size_t)(row0 + ai * HALF + m * 16) * ldc + col0;
#pragma unroll
                for (int bj = 0; bj < 2; ++bj) { f32x4 v0 = acc[ai][bj][m][0] + bv[bj][0], v1 = acc[ai][bj][m][1] + bv[bj][1];
                    if (ACT == 1) { f32x2 a = gelu_pk((f32x2){v0[0], v0[1]}), b = gelu_pk((f32x2){v0[2], v0[3]}), c = gelu_pk((f32x2){v1[0], v1[1]}), d = gelu_pk((f32x2){v1[2], v1[3]});
                        v0 = (f32x4){a.x, a.y, b.x, b.y}; v1 = (f32x4){c.x, c.y, d.x, d.y}; }
                    v0 = v0 * sc; v1 = v1 * sc; u32x4 w; w.x = cvt_pk_bf16(v0[0], v0[1]); w.y = cvt_pk_bf16(v0[2], v0[3]); w.z = cvt_pk_bf16(v1[0], v1[1]); w.w = cvt_pk_bf16(v1[2], v1[3]);
                    *(u32x4*)(rowp + bj * HALF) = w; } }
    }
};
struct EpiF32 {
    static constexpr bool PERM = false, AFTER_DRAIN = false;
    float* O; int ldc;
    __device__ __forceinline__ void operator()(const f32x4 (&acc)[2][2][4][2], const Unit& u, int wr, int wc, int fr, int fq) const {
        const int col0 = u.pn * BM + wc * 32 + 4 * fq;
#pragma unroll
        for (int ai = 0; ai < 2; ++ai)
#pragma unroll
            for (int m = 0; m < 4; ++m) { float* rowp = O + (size_t)(u.pm * BM + ai * HALF + wr * 64 + m * 16 + fr) * ldc + col0;
#pragma unroll
                for (int bj = 0; bj < 2; ++bj)
#pragma unroll
                    for (int n = 0; n < 2; ++n) *(f32x4*)(rowp + bj * HALF + n * 16) = acc[ai][bj][m][n]; }
    }
};
struct PanelOrder {
    int r, c;
    __device__ __forceinline__ bool next(int i, Unit& u) const { if (i > 0) return false; const int x = c & 7, j = c >> 3; u.pm = 32 * r + 4 * x + (j >> 3); u.pn = j & 7; return true; }
    __device__ __forceinline__ void a_ready(const Unit&) const {}
    __device__ __forceinline__ void done(const Unit&) const {}
};
struct EpiRmsRes {
    static constexpr bool PERM = false, AFTER_DRAIN = true;
    const float* x; float* out; const float* g; const float* mod; unsigned* slots; unsigned* cnt;
    __device__ __forceinline__ void fused(f32x4 (&acc)[2][2][4][2], const Unit& u, int wr, int wc, int fr, int fq, PG8_LAS unsigned char* lds, int wid, int lane) const {
        PG8_LAS float* P = (PG8_LAS float*)lds;
        PG8_LAS float* S = (PG8_LAS float*)(lds + 4096);
        const int tid = wid * 64 + lane;
#pragma unroll
        for (int ai = 0; ai < 2; ++ai)
#pragma unroll
            for (int m = 0; m < 4; ++m) { float s = 0.f;
#pragma unroll
                for (int bj = 0; bj < 2; ++bj)
#pragma unroll
                    for (int n = 0; n < 2; ++n) { const f32x4 v = acc[ai][bj][m][n]; s += (v[0] * v[0] + v[1] * v[1]) + (v[2] * v[2] + v[3] * v[3]); }
                s += __shfl_xor(s, 16); s += __shfl_xor(s, 32);
                if (fq == 0) P[(ai * HALF + wr * 64 + m * 16 + fr) * 4 + wc] = s; }
        asm volatile("s_waitcnt lgkmcnt(0)" ::: "memory"); __builtin_amdgcn_s_barrier(); asm volatile("" ::: "memory");
        if (tid < 256) { const f32x4 p = *(const PG8_LAS f32x4*)(P + tid * 4);
            __hip_atomic_store(slots + ((size_t)(u.pm * BM + tid) * 8 + u.pn), __builtin_bit_cast(unsigned, (p[0] + p[1]) + (p[2] + p[3])), __ATOMIC_RELAXED, __HIP_MEMORY_SCOPE_AGENT); }
        asm volatile("s_waitcnt vmcnt(0)" ::: "memory");
        if (lane == 0) __hip_atomic_fetch_add(cnt + 64 * u.pm, 1u, __ATOMIC_RELAXED, __HIP_MEMORY_SCOPE_AGENT);
        if (wid == 0) { unsigned sp = 0;
            while ((unsigned)__builtin_amdgcn_readfirstlane((int)__hip_atomic_load(cnt + 64 * u.pm, __ATOMIC_RELAXED, __HIP_MEMORY_SCOPE_AGENT)) < 64u) { __builtin_amdgcn_s_sleep(2); if (++sp > (1u << 22)) break; }
            __builtin_amdgcn_fence(__ATOMIC_ACQUIRE, "agent"); }
        asm volatile("s_waitcnt vmcnt(0) lgkmcnt(0)" ::: "memory"); __builtin_amdgcn_s_barrier(); asm volatile("" ::: "memory");
        if (tid < 256) { const unsigned* sl = slots + (size_t)(u.pm * BM + tid) * 8; float t = 0.f;
#pragma unroll
            for (int q = 0; q < 8; ++q) t += __builtin_bit_cast(float, __hip_atomic_load(sl + q, __ATOMIC_RELAXED, __HIP_MEMORY_SCOPE_AGENT));
            S[tid] = __builtin_amdgcn_rsqf(t * (1.0f / 2048.0f) + 1e-6f); }
        asm volatile("s_waitcnt lgkmcnt(0)" ::: "memory"); __builtin_amdgcn_s_barrier(); asm volatile("" ::: "memory");
        const int col0 = u.pn * BM + wc * 32 + 4 * fq; const float* gt = mod + (size_t)(u.pm >> 3) * 6144 + 4096;
        f32x4 gg[2][2];
#pragma unroll
        for (int bj = 0; bj < 2; ++bj)
#pragma unroll
            for (int n = 0; n < 2; ++n) gg[bj][n] = *(const f32x4*)(g + col0 + bj * HALF + n * 16) * *(const f32x4*)(gt + col0 + bj * HALF + n * 16);
#pragma unroll
        for (int ai = 0; ai < 2; ++ai)
#pragma unroll
            for (int m = 0; m < 4; ++m) { const int r = ai * HALF + wr * 64 + m * 16 + fr; const float rinv = S[r]; const size_t off = (size_t)(u.pm * BM + r) * 2048 + col0;
#pragma unroll
                for (int bj = 0; bj < 2; ++bj)
#pragma unroll
                    for (int n = 0; n < 2; ++n) *(f32x4*)(out + off + bj * HALF + n * 16) = *(const f32x4*)(x + off + bj * HALF + n * 16) + gg[bj][n] * (acc[ai][bj][m][n] * rinv);
                if (m & 1) asm volatile("" ::: "memory"); }
    }
};
template <class Epi, class Sched, bool ALIGN_EPI = false, bool SP2 = false>
__device__ __forceinline__ void gemm_phase(PG8_LAS unsigned char* lds, const Gemm g, const Sched& S, const Epi& E) {
    const int tid = threadIdx.x, wid = __builtin_amdgcn_readfirstlane(tid >> 6), lane = tid & 63, wr = wid >> 2, wc = wid & 3, fr = lane & 15, fq = lane >> 4;
    const int K = g.K, nt = K / BK;
    unsigned voffA[2], voffB[2];
#pragma unroll
    for (int i = 0; i < 2; ++i) { int R, C; stage_rc(tid * 16 + i * 8192, R, C); const int Rb = Epi::PERM ? ((R & ~31) + perm32(R & 31)) : R;
        voffA[i] = (unsigned)(R * K + C) * 2u; voffB[i] = (unsigned)(Rb * K + C) * 2u; }
    const size_t kstep = (size_t)(BK * 2);
    const size_t hstep = (size_t)HALF * K * 2;
    const size_t tstep = 2 * hstep;
    const unsigned ldsw = (unsigned)wid * 1024u;
    const int aoff = lds_byte(wr * 64 + fr, fq * 8), boff = lds_byte(wc * 32 + fr, fq * 8);
#define PG8_SA(b, h) (((b) * 2 + (h)) * HTB)
#define PG8_SB(b, h) ((4 + (b) * 2 + (h)) * HTB)
#define PG8_STAGE(bufoff, gbase, voff) do { _Pragma("unroll") for (int _i = 0; _i < 2; ++_i) \
        __builtin_amdgcn_global_load_lds((const unsigned*)((const char*)(gbase) + (voff)[_i]), (PG8_LAS unsigned*)(lds + (bufoff) + ldsw + _i * 8192), 16, 0, 0); } while (0)
#define PG8_LDA(dst, b, h) do { _Pragma("unroll") for (int m = 0; m < 4; ++m) _Pragma("unroll") for (int k = 0; k < 2; ++k) dst[m][k] = *(const PG8_LAS bf16x8*)(lds + PG8_SA(b, h) + aoff + m * 2048 + k * 1024); } while (0)
#define PG8_LDB(dst, b, h) do { _Pragma("unroll") for (int n = 0; n < 2; ++n) _Pragma("unroll") for (int k = 0; k < 2; ++k) dst[n][k] = *(const PG8_LAS bf16x8*)(lds + PG8_SB(b, h) + boff + n * 2048 + k * 1024); } while (0)
#define PG8_MMA(ai, bj, At, Bt) do { __builtin_amdgcn_s_setprio(1); _Pragma("unroll") for (int m = 0; m < 4; ++m) _Pragma("unroll") for (int n = 0; n < 2; ++n) _Pragma("unroll") for (int k = 0; k < 2; ++k) \
        acc[ai][bj][m][n] = __builtin_amdgcn_mfma_f32_16x16x32_bf16(Bt[n][k], At[m][k], acc[ai][bj][m][n], 0, 0, 0); __builtin_amdgcn_s_setprio(0); } while (0)
#define PG8_WAIT_V(n) asm volatile("s_waitcnt vmcnt(" #n ")" ::: "memory")
#define PG8_WAIT_L(n) asm volatile("s_waitcnt lgkmcnt(" #n ")" ::: "memory")
#define PG8_BAR __builtin_amdgcn_s_barrier()
#define PG8_SCHED __builtin_amdgcn_sched_barrier(0)
    Unit cur, nxt; int ui = 0;
    if (!S.next(0, cur)) return;
    f32x4 acc[2][2][4][2];
#pragma unroll
    for (int a = 0; a < 2; ++a)
#pragma unroll
        for (int b = 0; b < 2; ++b)
#pragma unroll
            for (int m = 0; m < 4; ++m)
#pragma unroll
                for (int n = 0; n < 2; ++n) acc[a][b][m][n] = (f32x4){0.f, 0.f, 0.f, 0.f};
    bf16x8 At[4][2], B0[2][2], B1[2][2];
    const char* cA = (const char*)g.A + (size_t)cur.pm * tstep; const char* cB = (const char*)g.Bt + (size_t)cur.pn * tstep;
    S.a_ready(cur);
    if constexpr (SP2) {
        PG8_STAGE(PG8_SB(0, 0), cB, voffB); PG8_STAGE(PG8_SB(0, 1), cB + hstep, voffB); PG8_STAGE(PG8_SA(0, 0), cA, voffA); PG8_STAGE(PG8_SA(0, 1), cA + hstep, voffA);
        if (wr == 1) PG8_BAR;
        PG8_WAIT_V(2); PG8_BAR;
        PG8_STAGE(PG8_SB(1, 0), cB + kstep, voffB); PG8_STAGE(PG8_SA(1, 0), cA + kstep, voffA); PG8_STAGE(PG8_SB(1, 1), cB + hstep + kstep, voffB);
        PG8_WAIT_V(6); PG8_BAR;
    } else {
        PG8_STAGE(PG8_SB(0, 0), cB, voffB); PG8_STAGE(PG8_SA(0, 0), cA, voffA); PG8_STAGE(PG8_SB(0, 1), cB + hstep, voffB); PG8_STAGE(PG8_SA(0, 1), cA + hstep, voffA);
        if (wr == 1) PG8_BAR;
        PG8_WAIT_V(4); PG8_BAR;
        PG8_STAGE(PG8_SB(1, 0), cB + kstep, voffB); PG8_STAGE(PG8_SA(1, 0), cA + kstep, voffA); PG8_STAGE(PG8_SB(1, 1), cB + hstep + kstep, voffB);
        PG8_WAIT_V(6); PG8_BAR;
    }
    for (;;) {
        const bool has_next = S.next(ui + 1, nxt);
        const char* nA = has_next ? (const char*)g.A + (size_t)nxt.pm * tstep : cA; const char* nB = has_next ? (const char*)g.Bt + (size_t)nxt.pn * tstep : cB;
        for (int t = 0; t < nt; t += 2) {
            const bool last = (t == nt - 2);
            const char* a1 = cA + (size_t)(t + 1) * kstep;
            const char* a2 = last ? nA : cA + (size_t)(t + 2) * kstep; const char* b2 = last ? nB : cB + (size_t)(t + 2) * kstep;
            const char* a3 = a2 + kstep; const char* b3 = b2 + kstep;
            if (last && has_next) S.a_ready(nxt);
            if constexpr (SP2) {
            PG8_LDB(B0, 0, 0); PG8_LDB(B1, 0, 1); PG8_SCHED; PG8_LDA(At, 0, 0); PG8_STAGE(PG8_SA(1, 1), a1 + hstep, voffA);
            PG8_WAIT_V(8); PG8_WAIT_L(0); PG8_BAR; PG8_MMA(0, 0, At, B0); PG8_MMA(0, 1, At, B1); PG8_BAR; PG8_SCHED;
            PG8_LDA(At, 0, 1); PG8_STAGE(PG8_SB(0, 0), b2, voffB); PG8_STAGE(PG8_SB(0, 1), b2 + hstep, voffB); PG8_STAGE(PG8_SA(0, 0), a2, voffA);
            PG8_WAIT_V(8); PG8_WAIT_L(0); PG8_BAR; PG8_MMA(1, 0, At, B0); PG8_MMA(1, 1, At, B1); PG8_BAR; PG8_SCHED;
            PG8_LDB(B0, 1, 0); PG8_LDB(B1, 1, 1); PG8_SCHED; PG8_LDA(At, 1, 0); PG8_STAGE(PG8_SA(0, 1), a2 + hstep, voffA);
            PG8_WAIT_V(8); PG8_WAIT_L(0); PG8_BAR; PG8_MMA(0, 0, At, B0); PG8_MMA(0, 1, At, B1); PG8_BAR; PG8_SCHED;
            PG8_LDA(At, 1, 1); PG8_STAGE(PG8_SB(1, 0), b3, voffB); PG8_STAGE(PG8_SB(1, 1), b3 + hstep, voffB); PG8_STAGE(PG8_SA(1, 0), a3, voffA);
            PG8_WAIT_V(8); PG8_WAIT_L(0); PG8_BAR; PG8_MMA(1, 0, At, B0); PG8_MMA(1, 1, At, B1); PG8_BAR; PG8_SCHED;
            } else {
            PG8_LDB(B0, 0, 0); PG8_SCHED; PG8_LDA(At, 0, 0); PG8_STAGE(PG8_SA(1, 1), a1 + hstep, voffA);
            PG8_WAIT_L(8); PG8_BAR; PG8_WAIT_L(0); PG8_MMA(0, 0, At, B0); PG8_BAR; PG8_SCHED;
            PG8_LDB(B1, 0, 1); PG8_STAGE(PG8_SB(0, 0), b2, voffB);
            PG8_BAR; PG8_WAIT_L(0); PG8_MMA(0, 1, At, B1); PG8_BAR;
            PG8_LDA(At, 0, 1); PG8_STAGE(PG8_SA(0, 0), a2, voffA);
            PG8_BAR; PG8_WAIT_L(0); PG8_MMA(1, 0, At, B0); PG8_BAR; PG8_SCHED;
            PG8_STAGE(PG8_SB(0, 1), b2 + hstep, voffB);
            PG8_WAIT_V(6); PG8_BAR; PG8_MMA(1, 1, At, B1); PG8_BAR;
            PG8_LDB(B0, 1, 0); PG8_SCHED; PG8_LDA(At, 1, 0); PG8_STAGE(PG8_SA(0, 1), a2 + hstep, voffA);
            PG8_WAIT_L(8); PG8_BAR; PG8_WAIT_L(0); PG8_MMA(0, 0, At, B0); PG8_BAR; PG8_SCHED;
            PG8_LDB(B1, 1, 1); PG8_STAGE(PG8_SB(1, 0), b3, voffB);
            PG8_BAR; PG8_WAIT_L(0); PG8_MMA(0, 1, At, B1); PG8_BAR;
            PG8_LDA(At, 1, 1); PG8_STAGE(PG8_SA(1, 0), a3, voffA);
            PG8_BAR; PG8_WAIT_L(0); PG8_MMA(1, 0, At, B0); PG8_BAR; PG8_SCHED;
            PG8_STAGE(PG8_SB(1, 1), b3 + hstep, voffB);
            PG8_WAIT_V(6); PG8_BAR; PG8_MMA(1, 1, At, B1); PG8_BAR;
            }
        }
        if constexpr (ALIGN_EPI) { if (wr == 0) PG8_BAR; }
        if constexpr (!Epi::AFTER_DRAIN) { E(acc, cur, wr, wc, fr, fq); S.done(cur); }
        if (!has_next) break;
#pragma unroll
        for (int a = 0; a < 2; ++a)
#pragma unroll
            for (int b = 0; b < 2; ++b)
#pragma unroll
                for (int m = 0; m < 4; ++m)
#pragma unroll
                    for (int n = 0; n < 2; ++n) acc[a][b][m][n] = (f32x4){0.f, 0.f, 0.f, 0.f};
        cur = nxt; cA = nA; cB = nB; ++ui;
        if constexpr (ALIGN_EPI) { if (wr == 1) PG8_BAR; }
    }
    PG8_WAIT_V(0);
    if constexpr (!ALIGN_EPI) { if (wr == 0) PG8_BAR; }
    PG8_BAR;
    if constexpr (Epi::AFTER_DRAIN) { E.fused(acc, cur, wr, wc, fr, fq, lds, wid, lane); S.done(cur); }
#undef PG8_SA
#undef PG8_SB
#undef PG8_STAGE
#undef PG8_LDA
#undef PG8_LDB
#undef PG8_MMA
#undef PG8_WAIT_V
#undef PG8_WAIT_L
#undef PG8_BAR
#undef PG8_SCHED
}
}
#define GAS __attribute__((address_space(1)))
#define LAS __attribute__((address_space(3)))
typedef unsigned short bf16;
typedef unsigned v4u __attribute__((ext_vector_type(4)));
typedef unsigned v2u __attribute__((ext_vector_type(2)));
typedef float f32x4 __attribute__((ext_vector_type(4)));
typedef float f32x2 __attribute__((ext_vector_type(2)));
typedef short bf16x8 __attribute__((ext_vector_type(8)));
typedef short s16x4 __attribute__((ext_vector_type(4)));

constexpr int NB = 8, T = 2048, D = 2048, M = NB * T;
constexpr int NIN = 6784, NP = 6912;
constexpr int C_Q = 0, C_K = 1024, C_V = 1280, C_GA = 1536, C_R = 2560, C_RK = 3584, C_RV = 4608, C_WD = 5632, C_AD = 5696, C_GR = 5760;
constexpr size_t MiB = 1u << 20;
constexpr size_t WS_MOD = 0;
constexpr size_t WS_CTL = 512 * 1024, CTL_BYTES = 32768;
constexpr size_t WS_WIN = 2 * MiB;
constexpr size_t WS_WOUT = 29 * MiB;
constexpr size_t WS_H = 40 * MiB;
constexpr size_t WS_PROJ = 104 * MiB;
constexpr size_t WS_MIXOUT = 320 * MiB;
constexpr size_t WS_XW = 2 * MiB;
constexpr size_t WS_XA = 4 * MiB;
constexpr size_t WS_RN = 6 * MiB;
constexpr size_t WS_IMGA = 7 * MiB;
constexpr size_t WS_IMGB = 320 * MiB;
constexpr size_t WS_END = 500 * MiB;
constexpr int LDS_BYTES = 147456, RING_BYTES = 131072;
constexpr int NWAVES = 8;

__device__ __forceinline__ float rcp_f(float v) { return __builtin_amdgcn_rcpf(v); }
#define LDS_WAIT() asm volatile("s_waitcnt lgkmcnt(0)" ::: "memory")
__device__ __forceinline__ unsigned f2bf(float f) { unsigned u = __builtin_bit_cast(unsigned, f); return (u + 0x7fffu + ((u >> 16) & 1u)) >> 16; }
typedef __bf16 bf16x2_t __attribute__((ext_vector_type(2)));
__device__ __forceinline__ unsigned pk2(float lo, float hi) { const f32x2 v = {lo, hi}; return __builtin_bit_cast(unsigned, __builtin_convertvector(v, bf16x2_t)); }
__device__ __forceinline__ float tanh_f(float v) { return 1.f - 2.f * rcp_f(__expf(2.f * v) + 1.f); }
__device__ __forceinline__ float bflo(unsigned u) { return __builtin_bit_cast(float, u << 16); }
__device__ __forceinline__ float bfhi(unsigned u) { return __builtin_bit_cast(float, u & 0xffff0000u); }
__device__ __forceinline__ float silu_f(float v) { return v * rcp_f(1.f + __expf(-v)); }
__device__ __forceinline__ float wave_sum(float v) {
#pragma unroll
    for (int o = 1; o < 64; o <<= 1) v += __shfl_xor(v, o);
    return v;
}
template <int CTRL> __device__ __forceinline__ float dpp_add(float x) {
    const int y = __builtin_amdgcn_update_dpp(0, __builtin_bit_cast(int, x), CTRL, 0xF, 0xF, false);
    return x + __builtin_bit_cast(float, y);
}
__device__ __forceinline__ float reduce16(float x) {
    x = dpp_add<0x128>(x); x = dpp_add<0x124>(x); x = dpp_add<0x122>(x); x = dpp_add<0x121>(x);
    return x;
}
__device__ __forceinline__ float half_sum(float v) {
    v = reduce16(v); v += __shfl_xor(v, 16);
    return v;
}
struct Args { const float* in[19]; float* out; unsigned char* ws; };

__device__ __forceinline__ void p0_transpose_item(const float* W, int K, int N, bf16* WT, LAS float* scr, int item, int lane) {
    const int nblk = N / 32, kb = item / nblk, nb = item % nblk, k0 = 64 * kb, n0 = 32 * nb;
    float wv[32];
#pragma unroll
    for (int i = 0; i < 32; ++i) wv[i] = W[(size_t)(k0 + 2 * i + (lane >> 5)) * N + n0 + (lane & 31)];
#pragma unroll
    for (int i = 0; i < 32; ++i) scr[(2 * i + (lane >> 5)) * 33 + (lane & 31)] = wv[i];
    LDS_WAIT(); asm volatile("" ::: "memory");
    const int c = lane & 7;
#pragma unroll
    for (int j = 0; j < 4; ++j) { const int n = (lane >> 3) + 8 * j; const LAS float* s = scr + (8 * c) * 33 + n;
        v4u o; o.x = pk2(s[0 * 33], s[1 * 33]); o.y = pk2(s[2 * 33], s[3 * 33]); o.z = pk2(s[4 * 33], s[5 * 33]); o.w = pk2(s[6 * 33], s[7 * 33]);
        *(v4u*)(WT + (size_t)(n0 + n) * K + k0 + 8 * c) = o; }
    LDS_WAIT(); asm volatile("" ::: "memory");
}

__device__ __forceinline__ void phase0(LAS unsigned char* lds, const Args& a, int tid, int wave, int lane) {
    const float* c = a.in[1]; const float* w_ada = a.in[2]; const float* b_ada = a.in[3];
    float* mod = (float*)(a.ws + WS_MOD);
    if (blockIdx.x < 192) {
        LAS float* s = (LAS float*)lds;
        LAS float* red = s + 16384;
        for (int i = tid; i < 8 * 2048; i += 512) s[i] = silu_f(c[i]);
        __syncthreads();
        const int j = blockIdx.x, cgp = tid & 7, kp = tid >> 3;
        float acc[8][4];
#pragma unroll
        for (int b = 0; b < 8; ++b)
#pragma unroll
            for (int e = 0; e < 4; ++e) acc[b][e] = 0.f;
#pragma unroll 8
        for (int i = 0; i < 32; ++i) {
            const int k = kp + 64 * i;
            const f32x4 wv = *(const f32x4*)(w_ada + (size_t)k * 6144 + 32 * j + 4 * cgp);
#pragma unroll
            for (int b = 0; b < 8; ++b) { const float sv = s[b * 2048 + k];
#pragma unroll
                for (int e = 0; e < 4; ++e) acc[b][e] += sv * wv[e]; }
        }
#pragma unroll
        for (int b = 0; b < 8; ++b)
#pragma unroll
            for (int e = 0; e < 4; ++e) red[kp * 256 + b * 32 + 4 * cgp + e] = acc[b][e];
        __syncthreads();
        if (tid < 256) {
            float sum = 0.f;
            for (int q = 0; q < 64; ++q) sum += red[q * 256 + tid];
            const int b = tid >> 5, col = tid & 31;
            mod[b * 6144 + 32 * j + col] = sum + b_ada[32 * j + col];
        }
        __syncthreads();
    }
    LAS float* scr = (LAS float*)(lds + wave * 16384);
    const int gw = blockIdx.x * NWAVES + wave, NGW = gridDim.x * NWAVES;
    bf16* WinT = (bf16*)(a.ws + WS_WIN); bf16* WoutT = (bf16*)(a.ws + WS_WOUT);
    constexpr int I_IN = (D / 64) * (NIN / 32), I_OUT = (D / 64) * (D / 32);
    for (int it = gw; it < I_IN + I_OUT; it += NGW) {
        if (it < I_IN) p0_transpose_item(a.in[6], D, NIN, WinT, scr, it, lane);
        else p0_transpose_item(a.in[7], D, D, WoutT, scr, it - I_IN, lane);
    }
    { v4u* z = (v4u*)(WinT + (size_t)NIN * D); const int nz = (NP - NIN) * D * 2 / 16;
      for (int i = blockIdx.x * 512 + tid; i < nz; i += gridDim.x * 512) z[i] = (v4u){0u, 0u, 0u, 0u}; }
}

__device__ __forceinline__ void phase1(const Args& a, int wave, int lane) {
    const float* x = a.in[0]; const float* g = a.in[4];
    const float* mod = (const float*)(a.ws + WS_MOD); bf16* H = (bf16*)(a.ws + WS_H);
    const int gw = blockIdx.x * NWAVES + wave, NGW = gridDim.x * NWAVES;
    for (int m = gw; m < M; m += NGW) {
        const int b = m >> 11;
        const f32x4* xr = (const f32x4*)(x + (size_t)m * D) + lane;
        f32x4 v[8]; float ss = 0.f;
#pragma unroll
        for (int j = 0; j < 8; ++j) { v[j] = xr[64 * j]; ss += (v[j].x * v[j].x + v[j].y * v[j].y) + (v[j].z * v[j].z + v[j].w * v[j].w); }
        const float rinv = rsqrtf(wave_sum(ss) * (1.f / D) + 1e-6f);
        v2u* o8 = (v2u*)(H + (size_t)m * D) + lane;
#pragma unroll
        for (int j = 0; j < 8; ++j) {
            const int col = 4 * lane + 256 * j;
            const f32x4 g4 = *(const f32x4*)(g + col);
            const f32x4 sh = *(const f32x4*)(mod + b * 6144 + col);
            const f32x4 sc = *(const f32x4*)(mod + b * 6144 + 2048 + col);
            const f32x4 o = v[j] * rinv * g4 * (sc + 1.f) + sh;
            v2u w; w.x = pk2(o.x, o.y); w.y = pk2(o.z, o.w);
            o8[64 * j] = w;
        }
    }
}

__device__ __forceinline__ void attn_phase(LAS unsigned char* lds, const bf16* P, bf16* mix, const float* sinks, int u0, int ustride, int nunits, int tid, int wave, int lane) {
    constexpr int KP = 72, VP = 264;
    LAS bf16* Ks = (LAS bf16*)lds;
    LAS bf16* Vt = (LAS bf16*)(lds + 36864);
    const int c = lane & 15, hq = lane >> 4, g = wave >> 1, half = wave & 1;
    v4u kv[4], vv[4];
#define A_LOAD(uu) do { const int b_ = (uu) >> 6, n_ = ((uu) >> 2) & 15, hk_ = (uu) & 3; \
        _Pragma("unroll") for (int i = 0; i < 4; ++i) { const int idx = tid + 512 * i, key = idx >> 3, part = idx & 7, tok = (n_ - 1) * 128 + key; \
            kv[i] = (v4u){0u, 0u, 0u, 0u}; vv[i] = (v4u){0u, 0u, 0u, 0u}; \
            if (tok >= 0) { const size_t row = (size_t)(b_ * T + tok) * NP; kv[i] = *(const v4u*)(P + row + C_K + hk_ * 64 + part * 8); vv[i] = *(const v4u*)(P + row + C_V + hk_ * 64 + part * 8); } } } while (0)
    A_LOAD(u0);
    for (int ui = 0; ui < nunits; ++ui) {
        const int u = u0 + ui * ustride, b = u >> 6, n = (u >> 2) & 15, hk = u & 3, head = hk * 4 + g;
#pragma unroll
        for (int i = 0; i < 4; ++i) { const int idx = tid + 512 * i, key = idx >> 3, part = idx & 7;
            *(LAS v4u*)(Ks + key * KP + part * 8) = kv[i];
#pragma unroll
            for (int e = 0; e < 8; ++e) Vt[(part * 8 + e) * VP + key] = (bf16)((vv[i][e >> 1] >> (16 * (e & 1))) & 0xffffu); }
        __syncthreads();
        if (ui + 1 < nunits) A_LOAD(u + ustride);
        const float sink = sinks[head];
        const size_t rowq = (size_t)(b * T + n * 128 + half * 64 + c);
        bf16x8 qf[2], nqf[2]; v2u ga[4], nga[4];
#pragma unroll
        for (int ks = 0; ks < 2; ++ks) qf[ks] = *(const bf16x8*)(P + rowq * NP + C_Q + head * 64 + 32 * ks + 8 * hq);
#pragma unroll
        for (int dt = 0; dt < 4; ++dt) ga[dt] = *(const v2u*)(P + rowq * NP + C_GA + head * 64 + 16 * dt + 4 * hq);
        for (int ch = 0; ch < 4; ++ch) {
            const int q0 = half * 64 + ch * 16, tb = ((q0 >> 4) >> 1) * 2;
            if (ch + 1 < 4) { const size_t rn = (rowq + 16 * (ch + 1)) * NP;
#pragma unroll
                for (int ks = 0; ks < 2; ++ks) nqf[ks] = *(const bf16x8*)(P + rn + C_Q + head * 64 + 32 * ks + 8 * hq);
#pragma unroll
                for (int dt = 0; dt < 4; ++dt) nga[dt] = *(const v2u*)(P + rn + C_GA + head * 64 + 16 * dt + 4 * hq); }
            f32x4 s[10];
#pragma unroll
            for (int tl = 0; tl < 10; ++tl) {
                f32x4 acc = (f32x4){0.f, 0.f, 0.f, 0.f};
#pragma unroll
                for (int ks = 0; ks < 2; ++ks) { const bf16x8 kf = *(const LAS bf16x8*)(Ks + (16 * (tb + tl) + c) * KP + 32 * ks + 8 * hq);
                    acc = __builtin_amdgcn_mfma_f32_16x16x32_bf16(kf, qf[ks], acc, 0, 0, 0); }
                s[tl] = acc;
            }
            const int qi = q0 + c;
            float mx = sink;
#pragma unroll
            for (int tl = 0; tl < 10; ++tl)
#pragma unroll
                for (int r = 0; r < 4; ++r) { const int si = 16 * (tb + tl) + 4 * hq + r;
                    const bool valid = (si > qi) && (si <= qi + 128) && (n > 0 || si >= 128);
                    const float sv = valid ? s[tl][r] * 0.125f : -1e30f; s[tl][r] = sv; mx = fmaxf(mx, sv); }
            mx = fmaxf(mx, __shfl_xor(mx, 16)); mx = fmaxf(mx, __shfl_xor(mx, 32));
            float sum = 0.f;
#pragma unroll
            for (int tl = 0; tl < 10; ++tl)
#pragma unroll
                for (int r = 0; r < 4; ++r) { const float p = __expf(s[tl][r] - mx); s[tl][r] = p; sum += p; }
            sum += __shfl_xor(sum, 16); sum += __shfl_xor(sum, 32);
            const float inv = rcp_f(sum + __expf(sink - mx));
            f32x4 o[4];
#pragma unroll
            for (int dt = 0; dt < 4; ++dt) o[dt] = (f32x4){0.f, 0.f, 0.f, 0.f};
#pragma unroll
            for (int kp = 0; kp < 5; ++kp) {
                v4u pw; pw.x = pk2(s[2 * kp][0], s[2 * kp][1]); pw.y = pk2(s[2 * kp][2], s[2 * kp][3]); pw.z = pk2(s[2 * kp + 1][0], s[2 * kp + 1][1]); pw.w = pk2(s[2 * kp + 1][2], s[2 * kp + 1][3]);
                const bf16x8 pf = __builtin_bit_cast(bf16x8, pw);
#pragma unroll
                for (int dt = 0; dt < 4; ++dt) {
                    const v2u v0 = *(const LAS v2u*)(Vt + (16 * dt + c) * VP + 16 * (tb + 2 * kp) + 4 * hq);
                    const v2u v1 = *(const LAS v2u*)(Vt + (16 * dt + c) * VP + 16 * (tb + 2 * kp + 1) + 4 * hq);
                    v4u vw; vw.x = v0.x; vw.y = v0.y; vw.z = v1.x; vw.w = v1.y;
                    o[dt] = __builtin_amdgcn_mfma_f32_16x16x32_bf16(__builtin_bit_cast(bf16x8, vw), pf, o[dt], 0, 0, 0);
                }
            }
            bf16* orow = mix + (rowq + 16 * ch) * D + head * 64 + 4 * hq;
#pragma unroll
            for (int dt = 0; dt < 4; ++dt) {
                const float g0 = bflo(ga[dt].x), g1 = bfhi(ga[dt].x), g2 = bflo(ga[dt].y), g3 = bfhi(ga[dt].y);
                v2u w; w.x = pk2(o[dt][0] * inv * silu_f(g0), o[dt][1] * inv * silu_f(g1)); w.y = pk2(o[dt][2] * inv * silu_f(g2), o[dt][3] * inv * silu_f(g3));
                *(v2u*)(orow + 16 * dt) = w;
            }
#pragma unroll
            for (int ks = 0; ks < 2; ++ks) qf[ks] = nqf[ks];
#pragma unroll
            for (int dt = 0; dt < 4; ++dt) ga[dt] = nga[dt];
        }
        __syncthreads();
    }
#undef A_LOAD
}

#define XB_TMO      128
#define XB_XCNT(j)  (256  + 64 * (j))
#define XB_XSUB(j)  (1280 + 64 * (j))
#define XB_XGEN(j)  (2304 + 64 * (j))
#define XB_TOP      3328
#define XB_TOPGEN   3392
#define XCD_BAR_WORDS 3456
#define XB_SPIN_CAP (1u << 18)

__device__ __forceinline__ unsigned xb_ld(unsigned* p)              { return __hip_atomic_load(p, __ATOMIC_RELAXED, __HIP_MEMORY_SCOPE_AGENT); }
__device__ __forceinline__ unsigned xb_add(unsigned* p, unsigned v) { return __hip_atomic_fetch_add(p, v, __ATOMIC_RELAXED, __HIP_MEMORY_SCOPE_AGENT); }
__device__ __forceinline__ unsigned xb_xcc_id() { return (unsigned)__builtin_amdgcn_s_getreg((3 << 11) | 20) & 0xFu; }
#define XB_SPIN(cond, bar) do { unsigned _sp = 0; while (cond) { __builtin_amdgcn_s_sleep(1); \
    if ((++_sp & 255u) == 0u) { if (xb_ld(&(bar)[XB_TMO])) break; if (_sp > XB_SPIN_CAP) { atomicAdd(&(bar)[XB_TMO], 1u); break; } } } } while (0)

struct XcdBarrier {
    unsigned* bar; unsigned x;
    volatile LAS unsigned* st;
};

__device__ __forceinline__ XcdBarrier xcd_barrier_post(unsigned* bar, volatile LAS unsigned* st) {
    XcdBarrier b; b.bar = bar; b.x = xb_xcc_id(); b.st = st;
    if (threadIdx.x == 0) (void)xb_add(&bar[XB_XCNT(b.x)], 1u);
    return b;
}
__device__ __forceinline__ void xcd_barrier_complete(unsigned* bar, unsigned x, unsigned& nloc, unsigned& nx) {
    const unsigned G = gridDim.x * gridDim.y * gridDim.z;
    unsigned sum, cnt, mine, sp = 0u;
    for (;;) {
        sum = 0u; cnt = 0u; mine = 0u;
#pragma unroll
        for (unsigned j = 0; j < 16; ++j) { const unsigned c = xb_ld(&bar[XB_XCNT(j)]); sum += c; cnt += (c > 0u) ? 1u : 0u; mine = (j == x) ? c : mine; }
        if (sum == G) break;
        __builtin_amdgcn_s_sleep(1);
        if ((++sp & 255u) == 0u) { if (xb_ld(&bar[XB_TMO])) break; if (sp > XB_SPIN_CAP) { atomicAdd(&bar[XB_TMO], 1u); break; } }
    }
    nloc = mine > 0u ? mine : 1u; nx = cnt > 0u ? cnt : 1u;
}

__device__ __forceinline__ void xcd_barrier(const XcdBarrier& b) {
    asm volatile("s_waitcnt vmcnt(0)" ::: "memory");
    __syncthreads();
    if (threadIdx.x == 0) {
        unsigned* bar = b.bar;
        __builtin_amdgcn_s_waitcnt(0);
        unsigned nloc = b.st[0], nx = b.st[1];
        if (nloc == 0u) { xcd_barrier_complete(bar, b.x, nloc, nx); b.st[0] = nloc; b.st[1] = nx; }
        const unsigned old = xb_add(&bar[XB_XSUB(b.x)], 1u);
        const unsigned gen = old / nloc;
        if (old + 1u == (gen + 1u) * nloc) {
            __builtin_amdgcn_fence(__ATOMIC_RELEASE, "agent");
            asm volatile("s_waitcnt vmcnt(0)" ::: "memory");
            const unsigned og = xb_add(&bar[XB_TOP], 1u);
            const unsigned tg = og / nx;
            if (og + 1u == (tg + 1u) * nx) xb_add(&bar[XB_TOPGEN], 1u);
            else XB_SPIN(xb_ld(&bar[XB_TOPGEN]) == tg, bar);
            __builtin_amdgcn_fence(__ATOMIC_ACQUIRE, "agent");
            xb_add(&bar[XB_XGEN(b.x)], 1u);
            asm volatile("s_waitcnt vmcnt(0)" ::: "memory");
        } else {
            XB_SPIN(xb_ld(&bar[XB_XGEN(b.x)]) == gen, bar);
            __builtin_amdgcn_fence(__ATOMIC_ACQUIRE, "agent");
            asm volatile("s_waitcnt vmcnt(0)" ::: "memory");
        }
    }
    __syncthreads();
}
__device__ __forceinline__ void phase25(const Args& a, int wave, int lane) {
    const bf16* P = (const bf16*)(a.ws + WS_PROJ);
    bf16* XW = (bf16*)(a.ws + WS_XW); bf16* XA = (bf16*)(a.ws + WS_XA); float* RN = (float*)(a.ws + WS_RN);
    const float* mu = a.in[9]; const float* k_k = a.in[14];
    const float mu_w = mu[3072 + lane], mu_a = mu[3136 + lane];
    float muk[16], kkc[16];
#pragma unroll
    for (int j = 0; j < 16; ++j) { muk[j] = mu[1024 + lane * 16 + j]; kkc[j] = k_k[lane * 16 + j]; }
    const int gw = blockIdx.x * NWAVES + wave, NGW = gridDim.x * NWAVES;
    for (int m = gw; m < M; m += NGW) {
        const bool first = (m & (T - 1)) == 0;
        const bf16* pr = P + (size_t)m * NP;
        const float wc = bflo((unsigned)pr[C_WD + lane]), ac = bflo((unsigned)pr[C_AD + lane]);
        const float wp = first ? 0.f : bflo((unsigned)pr[C_WD + lane - NP]), ap = first ? 0.f : bflo((unsigned)pr[C_AD + lane - NP]);
        XW[(size_t)m * 64 + lane] = (bf16)f2bf(tanh_f(wc + (wp - wc) * mu_w));
        XA[(size_t)m * 64 + lane] = (bf16)f2bf(ac + (ap - ac) * mu_a);
        v4u kc[2], kp[2];
#pragma unroll
        for (int h = 0; h < 2; ++h) { kc[h] = *(const v4u*)(pr + C_RK + lane * 16 + 8 * h);
            kp[h] = first ? (v4u){0u, 0u, 0u, 0u} : *(const v4u*)(pr - NP + C_RK + lane * 16 + 8 * h); }
        float ssq = 0.f;
#pragma unroll
        for (int h = 0; h < 2; ++h)
#pragma unroll
            for (int j = 0; j < 4; ++j) {
                const float c0 = bflo(kc[h][j]), c1 = bfhi(kc[h][j]), p0 = bflo(kp[h][j]), p1 = bfhi(kp[h][j]);
                const float k0 = (c0 + (p0 - c0) * muk[8 * h + 2 * j]) * kkc[8 * h + 2 * j], k1 = (c1 + (p1 - c1) * muk[8 * h + 2 * j + 1]) * kkc[8 * h + 2 * j + 1];
                ssq += k0 * k0 + k1 * k1; }
        ssq = dpp_add<0xB1>(ssq); ssq = dpp_add<0x4E>(ssq);
        if ((lane & 3) == 0) RN[(size_t)m * 16 + (lane >> 2)] = rsqrtf(fmaxf(ssq, 1e-24f));
    }
}

constexpr int TC = 16, NCH = T / TC;
constexpr int IMG = 12864, I_PA = 0, I_A2 = 4096, I_V = 8192, I_DE = 12288, I_SC = 12544, I_BON = 12800;
constexpr int STG = 14144, P_SC = 12864, P_BON = 13888;
#define WG_BAR() do { asm volatile("s_waitcnt lgkmcnt(0)" ::: "memory"); __builtin_amdgcn_s_barrier(); asm volatile("" ::: "memory"); } while (0)
__device__ __forceinline__ unsigned char* img_ptr(unsigned char* ws, int chain, int chunk) {
    return chain < 14 ? ws + WS_IMGA + ((size_t)chain * NCH + chunk) * IMG : ws + WS_IMGB + ((size_t)(chain - 14) * NCH + chunk) * IMG;
}

__device__ __forceinline__ void rwkv_prepass(LAS unsigned char* lds, const Args& a, int tid, int wave, int lane, int cb, int nch, int G, int bidx) {
    const bf16* P = (const bf16*)(a.ws + WS_PROJ);
    const bf16* XW = (const bf16*)(a.ws + WS_XW); const bf16* XA = (const bf16*)(a.ws + WS_XA); const float* RN = (const float*)(a.ws + WS_RN);
    const int g = wave >> 2, hw = wave & 3, grp = bidx * 2 + g, gpc = G >> 6, ntask = nch / gpc, chain = grp / gpc, c0 = cb + (grp % gpc) * ntask;
    const int b = chain >> 4; const unsigned hh = chain & 15, rowbase = (unsigned)b * T;
    const unsigned cc = lane & 15, hq = lane >> 4; const int ch = 16 * hw + (int)cc; const unsigned col = hh * 64 + ch; const int tg = tid & 255;
    const float* mu = a.in[9];
    const float cw0 = a.in[10][col], ca0 = a.in[12][col], ckk = a.in[14][col], cka = a.in[15][col], crk = a.in[16][col];
    const float mur = mu[col], muk = mu[1024 + col], muv = mu[2048 + col];
    bf16x8 bwf[2], baf[2];
#pragma unroll
    for (int ks = 0; ks < 2; ++ks) {
        float tw[8], ta[8];
#pragma unroll
        for (int j = 0; j < 8; ++j) { const size_t o = (size_t)(32 * ks + 8 * hq + j) * 1024 + col; tw[j] = a.in[11][o]; ta[j] = a.in[13][o]; }
        v4u w; w.x = pk2(tw[0], tw[1]); w.y = pk2(tw[2], tw[3]); w.z = pk2(tw[4], tw[5]); w.w = pk2(tw[6], tw[7]); bwf[ks] = __builtin_bit_cast(bf16x8, w);
        v4u v; v.x = pk2(ta[0], ta[1]); v.y = pk2(ta[2], ta[3]); v.z = pk2(ta[4], ta[5]); v.w = pk2(ta[6], ta[7]); baf[ks] = __builtin_bit_cast(bf16x8, v);
    }
    const int pa_w = (hw >> 1) * 256 + (cc >> 2) * 16 + ((hw & 1) * 4 + (cc & 3)) * 2;
    v4u n_aw[2], n_aa[2], c_aw[2], c_aa[2], m_aw[2], m_aa[2];
    unsigned n_rc[4], n_kc[4], n_vc[4], n_rp, n_kp, n_vp, c_rc[4], c_kc[4], c_vc[4], c_rp, c_kp, c_vp, m_rc[4], m_kc[4], m_vc[4], m_rp, m_kp, m_vp;
    float n_rn[4], c_rn[4], m_rn[4];
#define H_LOAD(k) do { const unsigned t0_ = (unsigned)(k) * TC; const unsigned ra_ = (rowbase + t0_ + cc) * 64u + 8u * hq; \
        _Pragma("unroll") for (int ks = 0; ks < 2; ++ks) { n_aw[ks] = *(const v4u*)(XW + (ra_ + 32u * ks)); n_aa[ks] = *(const v4u*)(XA + (ra_ + 32u * ks)); } \
        const unsigned tb_ = t0_ + 4u * hq, pe_ = (rowbase + tb_) * (unsigned)NP + col; \
        _Pragma("unroll") for (int r = 0; r < 4; ++r) { n_rc[r] = P[pe_ + (unsigned)(r * NP + C_R)]; n_kc[r] = P[pe_ + (unsigned)(r * NP + C_RK)]; n_vc[r] = P[pe_ + (unsigned)(r * NP + C_RV)]; \
            n_rn[r] = RN[(rowbase + tb_ + r) * 16u + hh]; } \
        if (tb_ > 0u) { n_rp = P[pe_ - (unsigned)(NP - C_R)]; n_kp = P[pe_ - (unsigned)(NP - C_RK)]; n_vp = P[pe_ - (unsigned)(NP - C_RV)]; } else { n_rp = 0u; n_kp = 0u; n_vp = 0u; } \
    } while (0)
#define H_ADV() do { _Pragma("unroll") for (int ks = 0; ks < 2; ++ks) { c_aw[ks] = m_aw[ks]; c_aa[ks] = m_aa[ks]; m_aw[ks] = n_aw[ks]; m_aa[ks] = n_aa[ks]; } \
        _Pragma("unroll") for (int r = 0; r < 4; ++r) { c_rc[r] = m_rc[r]; c_kc[r] = m_kc[r]; c_vc[r] = m_vc[r]; c_rn[r] = m_rn[r]; m_rc[r] = n_rc[r]; m_kc[r] = n_kc[r]; m_vc[r] = n_vc[r]; m_rn[r] = n_rn[r]; } \
        c_rp = m_rp; c_kp = m_kp; c_vp = m_vp; m_rp = n_rp; m_kp = n_kp; m_vp = n_vp; } while (0)
    H_LOAD(c0); H_ADV(); H_LOAD(c0 + 1);
    for (int k = 0; k < ntask; ++k) {
        LAS unsigned char* B_ = lds + (g * 2 + (k & 1)) * STG;
        H_ADV();
        if (k + 2 < ntask) H_LOAD(c0 + k + 2);
        f32x4 accw = (f32x4){0.f, 0.f, 0.f, 0.f}, acca = (f32x4){0.f, 0.f, 0.f, 0.f};
#pragma unroll
        for (int ks = 0; ks < 2; ++ks) { accw = __builtin_amdgcn_mfma_f32_16x16x32_bf16(__builtin_bit_cast(bf16x8, c_aw[ks]), bwf[ks], accw, 0, 0, 0);
            acca = __builtin_amdgcn_mfma_f32_16x16x32_bf16(__builtin_bit_cast(bf16x8, c_aa[ks]), baf[ks], acca, 0, 0, 0); }
        float dec_[4], rr_[4], vx_[4], kkn_[4], k2_[4], bv_[4], pbo_[4], psc_[2][8];
#pragma unroll
        for (int r = 0; r < 4; ++r) {
            const float rcu = bflo(c_rc[r]), kcu = bflo(c_kc[r]), vcu = bflo(c_vc[r]);
            const float rpv = bflo(r == 0 ? c_rp : c_rc[r > 0 ? r - 1 : 0]), kpv = bflo(r == 0 ? c_kp : c_kc[r > 0 ? r - 1 : 0]), vpv = bflo(r == 0 ? c_vp : c_vc[r > 0 ? r - 1 : 0]);
            const float rr = rcu + (rpv - rcu) * mur, kx = kcu + (kpv - kcu) * muk; vx_[r] = vcu + (vpv - vcu) * muv;
            dec_[r] = __expf(-0.60653066f * rcp_f(1.f + __expf(-(cw0 + accw[r]))));
            const float ic = rcp_f(1.f + __expf(-(ca0 + acca[r])));
            const float kkn = kx * ckk * c_rn[r], k2 = kx * (1.f + (ic - 1.f) * cka), bv = kkn * ic;
            rr_[r] = rr; kkn_[r] = kkn; k2_[r] = k2; bv_[r] = bv;
            pbo_[r] = reduce16(rr * k2 * crk); }
#pragma unroll
        for (int pl = 0; pl < 2; ++pl) { const int r0 = 2 * pl, r1 = r0 + 1; const float wr1 = dec_[r1] * rr_[r1];
            psc_[pl][0] = reduce16(bv_[r0] * rr_[r0]); psc_[pl][1] = reduce16(k2_[r0] * rr_[r0]);
            psc_[pl][2] = reduce16(-bv_[r0] * kkn_[r1]); psc_[pl][3] = reduce16(-k2_[r0] * kkn_[r1]);
            psc_[pl][4] = reduce16(bv_[r0] * wr1); psc_[pl][5] = reduce16(k2_[r0] * wr1);
            psc_[pl][6] = reduce16(bv_[r1] * rr_[r1]); psc_[pl][7] = reduce16(k2_[r1] * rr_[r1]); }
        if (cc == 0) {
#pragma unroll
            for (int r = 0; r < 4; ++r) *(LAS float*)(B_ + P_BON + ((4 * hq + r) * 4 + hw) * 4) = pbo_[r];
#pragma unroll
            for (int pl = 0; pl < 2; ++pl)
#pragma unroll
                for (int e = 0; e < 8; ++e) *(LAS float*)(B_ + P_SC + (((2 * hq + pl) * 8 + e) * 4 + hw) * 4) = psc_[pl][e]; }
        { float D_[4], Dp_[4]; const float p0 = dec_[0], p1 = p0 * dec_[1], p2 = p1 * dec_[2], p3 = p2 * dec_[3];
          const float g0 = __shfl(p3, cc), g1 = __shfl(p3, cc + 16), g2 = __shfl(p3, cc + 32);
          const float E_ = hq == 0 ? 1.f : (hq == 1 ? g0 : (hq == 2 ? g0 * g1 : g0 * g1 * g2));
          D_[0] = E_ * p0; D_[1] = E_ * p1; D_[2] = E_ * p2; D_[3] = E_ * p3; Dp_[0] = E_; Dp_[1] = D_[0]; Dp_[2] = D_[1]; Dp_[3] = D_[2];
#pragma unroll
          for (int r = 0; r < 4; ++r) { const int pr_ = 2 * hq + (r >> 1), od = r & 1; const float rcp = rcp_f(D_[r]);
            const unsigned pw_ = pk2(-kkn_[r] * Dp_[r], D_[r] * rr_[r]);
            *(LAS bf16*)(B_ + I_PA + pr_ * 512 + od * 128 + pa_w) = (bf16)(pw_ & 0xffffu); *(LAS bf16*)(B_ + I_PA + pr_ * 512 + od * 128 + 64 + pa_w) = (bf16)(pw_ >> 16);
            *(LAS unsigned*)(B_ + I_A2 + (pr_ * 64 + ch) * 8 + od * 4) = pk2(bv_[r] * rcp, k2_[r] * rcp); *(LAS float*)(B_ + I_V + (pr_ * 64 + ch) * 8 + od * 4) = vx_[r]; }
          if (hq == 3) *(LAS float*)(B_ + I_DE + ch * 4) = D_[3]; }
        WG_BAR();
        unsigned char* gi = img_ptr(a.ws, chain, c0 + k);
#pragma unroll
        for (int i = 0; i < 3; ++i) *(v4u*)(gi + (tg + 256 * i) * 16) = *(const LAS v4u*)(B_ + (tg + 256 * i) * 16);
        if (tg < 16) *(v4u*)(gi + I_DE + tg * 16) = *(const LAS v4u*)(B_ + I_DE + tg * 16);
        else if (tg < 36) { const int j_ = tg - 16;
            const LAS unsigned char* pp_ = B_ + (j_ < 16 ? P_SC + j_ * 64 : P_BON + (j_ - 16) * 64);
            f32x4 o_;
#pragma unroll
            for (int e = 0; e < 4; ++e) { const f32x4 q_ = *(const LAS f32x4*)(pp_ + e * 16); o_[e] = (q_[0] + q_[1]) + (q_[2] + q_[3]); }
            *(f32x4*)(gi + (j_ < 16 ? I_SC + j_ * 16 : I_BON + (j_ - 16) * 16)) = o_; }
    }
    WG_BAR();
#undef H_LOAD
#undef H_ADV
}

constexpr int O_Y = 3 * IMG;
__device__ __forceinline__ void rwkv_block(LAS unsigned char* lds, const Args& a, int chain, int cbeg, int cend, f32x4 (&st)[4], int tid, int wave, int lane) {
    const int b = chain >> 4, hh = chain & 15, rowbase = b * T;
    if (wave < 4) {
        const int i = lane & 15, hq = lane >> 4, n = 16 * wave + i;
        const unsigned hmask = hq == 0 ? 0xffffffffu : 0u;
        const int pa_off = (i & 3) * 64 + hq * 16;
        const f32x4 zero4 = (f32x4){0.f, 0.f, 0.f, 0.f};
        WG_BAR();
        __builtin_amdgcn_s_setprio(3);
        int bi = 0;
        for (int c = cbeg; c < cend; ++c) {
            LAS unsigned char* B = lds + bi * IMG;
            LAS unsigned char* Yb = lds + O_Y + (c & 1) * 4096;
            const float scv = *(const LAS float*)(B + I_SC + lane * 4);
            bf16x8 pa0 = *(const LAS bf16x8*)(B + I_PA + pa_off), pa1 = *(const LAS bf16x8*)(B + I_PA + 256 + pa_off);
            f32x2 v2 = *(const LAS f32x2*)(B + I_V + n * 8);
            v2u a2[4];
#pragma unroll
            for (int q = 0; q < 4; ++q) a2[q] = *(const LAS v2u*)(B + I_A2 + (16 * q + i) * 8);
#pragma unroll
            for (int pp = 0; pp < TC / 2; ++pp) {
                bf16x8 npa0 = pa0, npa1 = pa1; f32x2 nv2 = v2; v2u na2[4];
#pragma unroll
                for (int q = 0; q < 4; ++q) na2[q] = a2[q];
                if (pp + 1 < TC / 2) {
                    npa0 = *(const LAS bf16x8*)(B + I_PA + ((pp + 1) * 2 + 0) * 256 + pa_off); npa1 = *(const LAS bf16x8*)(B + I_PA + ((pp + 1) * 2 + 1) * 256 + pa_off);
                    nv2 = *(const LAS f32x2*)(B + I_V + ((pp + 1) * 64 + n) * 8);
#pragma unroll
                    for (int q = 0; q < 4; ++q) na2[q] = *(const LAS v2u*)(B + I_A2 + ((pp + 1) * 64 + 16 * q + i) * 8);
                }
                __builtin_amdgcn_sched_barrier(0);
                v4u s0, s1;
                s0.x = pk2(st[0][0], st[0][1]); s0.y = pk2(st[0][2], st[0][3]); s0.z = pk2(st[1][0], st[1][1]); s0.w = pk2(st[1][2], st[1][3]);
                s1.x = pk2(st[2][0], st[2][1]); s1.y = pk2(st[2][2], st[2][3]); s1.z = pk2(st[3][0], st[3][1]); s1.w = pk2(st[3][2], st[3][3]);
                const f32x4 d0 = __builtin_amdgcn_mfma_f32_16x16x32_bf16(pa0, __builtin_bit_cast(bf16x8, s0), zero4, 0, 0, 0);
                const f32x4 d1 = __builtin_amdgcn_mfma_f32_16x16x32_bf16(pa1, __builtin_bit_cast(bf16x8, s1), zero4, 0, 0, 0);
                const f32x4 d = d0 + d1;
                float sc[8];
#pragma unroll
                for (int e = 0; e < 8; ++e) sc[e] = __builtin_bit_cast(float, __builtin_amdgcn_readlane(__builtin_bit_cast(int, scv), pp * 8 + e));
                const float sa0 = d[0];
                const float sa1 = d[2] + sa0 * sc[2] + v2[0] * sc[3];
                *(LAS float*)(Yb + ((2 * pp) * 64 + n) * 4) = d[1] + sa0 * sc[0] + v2[0] * sc[1];
                *(LAS float*)(Yb + ((2 * pp + 1) * 64 + n) * 4) = (d[3] + sa0 * sc[4] + v2[0] * sc[5]) + (sa1 * sc[6] + v2[1] * sc[7]);
                v2u bw; bw.x = pk2(sa0, v2[0]) & hmask; bw.y = pk2(sa1, v2[1]) & hmask;
                const s16x4 bfr = __builtin_bit_cast(s16x4, bw);
#pragma unroll
                for (int q = 0; q < 4; ++q) st[q] = __builtin_amdgcn_mfma_f32_16x16x16bf16_1k(__builtin_bit_cast(s16x4, a2[q]), bfr, st[q], 0, 0, 0);
                pa0 = npa0; pa1 = npa1; v2 = nv2;
#pragma unroll
                for (int q = 0; q < 4; ++q) a2[q] = na2[q];
            }
#pragma unroll
            for (int q = 0; q < 4; ++q) st[q] = st[q] * *(const LAS f32x4*)(B + I_DE + (16 * q + 4 * hq) * 4);
            bi = bi == 2 ? 0 : bi + 1;
            WG_BAR();
        }
        __builtin_amdgcn_s_setprio(0);
    } else {
        const bf16* P = (const bf16*)(a.ws + WS_PROJ); bf16* mix = (bf16*)(a.ws + WS_H);
        const int hw = wave - 4, cc = lane & 15, hq = lane >> 4, ch = 16 * hw + cc, col = hh * 64 + ch, tg = tid - 256;
        const float clw = a.in[17][col], clb = a.in[18][col];
        const unsigned char* ibase = img_ptr(a.ws, chain, 0);
        const bf16x8 ones8 = __builtin_bit_cast(bf16x8, (v4u){0x3f803f80u, 0x3f803f80u, 0x3f803f80u, 0x3f803f80u});
        v4u imA[3], itA = (v4u){0u, 0u, 0u, 0u}, imB[3], itB = (v4u){0u, 0u, 0u, 0u}; unsigned gE[4] = {0u, 0u, 0u, 0u}, gO[4] = {0u, 0u, 0u, 0u};
#define I_LOAD(im, it, k) do { const unsigned go_ = (unsigned)((k) * IMG); \
        _Pragma("unroll") for (int i_ = 0; i_ < 3; ++i_) im[i_] = *(const v4u*)(ibase + (go_ + (unsigned)((tg + 256 * i_) * 16))); \
        if (tg < 36) it = *(const v4u*)(ibase + (go_ + (unsigned)(I_DE + tg * 16))); } while (0)
#define I_STORE(im, it, bix) do { LAS unsigned char* B_ = lds + (bix) * IMG; \
        _Pragma("unroll") for (int i_ = 0; i_ < 3; ++i_) *(LAS v4u*)(B_ + (tg + 256 * i_) * 16) = im[i_]; \
        if (tg < 36) *(LAS v4u*)(B_ + I_DE + tg * 16) = it; } while (0)
#define H_GLOAD(gx, k) do { const unsigned pg_ = (unsigned)((rowbase + (k) * TC + 4 * hq) * NP + C_GR + col); \
        _Pragma("unroll") for (int r = 0; r < 4; ++r) gx[r] = P[pg_ + (unsigned)(r * NP)]; } while (0)
#define H_POST(gx, k, bix) do { LAS unsigned char* B_ = lds + (bix) * IMG; LAS unsigned char* Y_ = lds + O_Y + ((k) & 1) * 4096; \
          \
        f32x4 s1_ = (f32x4){0.f, 0.f, 0.f, 0.f}, s2_ = (f32x4){0.f, 0.f, 0.f, 0.f}; \
        _Pragma("unroll") for (int kb = 0; kb < 2; ++kb) { \
            const f32x4 ya = *(const LAS f32x4*)(Y_ + (cc * 64 + 32 * kb + 8 * hq) * 4), yb = *(const LAS f32x4*)(Y_ + (cc * 64 + 32 * kb + 8 * hq + 4) * 4); \
            v4u f1, f2; f1.x = pk2(ya[0], ya[1]); f1.y = pk2(ya[2], ya[3]); f1.z = pk2(yb[0], yb[1]); f1.w = pk2(yb[2], yb[3]); \
            f2.x = pk2(ya[0] * ya[0], ya[1] * ya[1]); f2.y = pk2(ya[2] * ya[2], ya[3] * ya[3]); f2.z = pk2(yb[0] * yb[0], yb[1] * yb[1]); f2.w = pk2(yb[2] * yb[2], yb[3] * yb[3]); \
            s1_ = __builtin_amdgcn_mfma_f32_16x16x32_bf16(__builtin_bit_cast(bf16x8, f1), ones8, s1_, 0, 0, 0); \
            s2_ = __builtin_amdgcn_mfma_f32_16x16x32_bf16(__builtin_bit_cast(bf16x8, f2), ones8, s2_, 0, 0, 0); } \
        _Pragma("unroll") for (int r = 0; r < 4; ++r) { const int t_ = 4 * hq + r; \
            const float yo = *(const LAS float*)(Y_ + (t_ * 64 + ch) * 4), vv = *(const LAS float*)(B_ + I_V + ((t_ >> 1) * 64 + ch) * 8 + (t_ & 1) * 4), bon = *(const LAS float*)(B_ + I_BON + t_ * 4); \
            const float mean = s1_[r] * (1.f / 64.f), var = fmaxf(s2_[r] * (1.f / 64.f) - mean * mean, 0.f), rs = rsqrtf(var + 64e-5f); \
            const float o_ = ((yo - mean) * rs * clw + clb + bon * vv) * silu_f(bflo(gx[r])); \
            mix[(unsigned)((rowbase + (k) * TC + t_) * D + 1024 + col)] = (bf16)(pk2(o_, o_) & 0xffffu); } \
    } while (0)
        I_LOAD(imA, itA, cbeg); I_STORE(imA, itA, 0);
        I_LOAD(imA, itA, cbeg + 1); I_LOAD(imB, itB, cbeg + 2);
        H_GLOAD(gE, cbeg);
        WG_BAR();
        int bi = 0;
        for (int c = cbeg; c < cend; c += 2) {
            {
                const int bn = bi == 2 ? 0 : bi + 1, bp = bi == 0 ? 2 : bi - 1;
                I_STORE(imA, itA, bn); if (c + 3 < cend) I_LOAD(imA, itA, c + 3);
                if (c > cbeg) H_POST(gO, c - 1, bp);
                H_GLOAD(gO, c + 1);
                bi = bn;
                WG_BAR();
            }
            {
                const int bn = bi == 2 ? 0 : bi + 1, bp = bi == 0 ? 2 : bi - 1;
                if (c + 2 < cend) { I_STORE(imB, itB, bn); if (c + 4 < cend) I_LOAD(imB, itB, c + 4); }
                H_POST(gE, c, bp);
                if (c + 2 < cend) H_GLOAD(gE, c + 2);
                bi = bn;
                WG_BAR();
            }
        }
        H_POST(gO, cend - 1, (bi == 0 ? 2 : bi - 1));
#undef I_LOAD
#undef I_STORE
#undef H_GLOAD
#undef H_POST
    }
    WG_BAR();
}

__device__ __forceinline__ void phase5(const Args& a, int wave, int lane) {
    const float* x = a.in[0]; const float* g = a.in[5];
    const float* mod = (const float*)(a.ws + WS_MOD); const bf16* MO = (const bf16*)(a.ws + WS_MIXOUT);
    const int gw = blockIdx.x * NWAVES + wave, NGW = gridDim.x * NWAVES;
    for (int m = gw; m < M; m += NGW) {
        const int b = m >> 11;
        const v4u* mr = (const v4u*)(MO + (size_t)m * D) + lane;
        const f32x4* xr = (const f32x4*)(x + (size_t)m * D);
        v4u mv[4]; f32x4 xv[8]; float ss = 0.f;
#pragma unroll
        for (int j = 0; j < 4; ++j) mv[j] = mr[64 * j];
#pragma unroll
        for (int j = 0; j < 4; ++j) { xv[2 * j] = xr[128 * j + 2 * lane]; xv[2 * j + 1] = xr[128 * j + 2 * lane + 1]; }
#pragma unroll
        for (int j = 0; j < 4; ++j)
#pragma unroll
            for (int e = 0; e < 4; ++e) { const float lo = bflo(mv[j][e]), hi = bfhi(mv[j][e]); ss += lo * lo + hi * hi; }
        const float rinv = rsqrtf(wave_sum(ss) * (1.f / D) + 1e-6f);
        f32x4* orow = (f32x4*)(a.out + (size_t)m * D);
#pragma unroll
        for (int j = 0; j < 4; ++j)
#pragma unroll
            for (int h = 0; h < 2; ++h) {
                const int col = 512 * j + 8 * lane + 4 * h;
                const f32x4 g4 = *(const f32x4*)(g + col);
                const f32x4 gt = *(const f32x4*)(mod + b * 6144 + 4096 + col);
                const f32x4 v = (f32x4){bflo(mv[j][2 * h]), bfhi(mv[j][2 * h]), bflo(mv[j][2 * h + 1]), bfhi(mv[j][2 * h + 1])};
                orow[128 * j + 2 * lane + h] = xv[2 * j + h] + gt * (v * rinv * g4);
            }
    }
}

__device__ __forceinline__ void sub_barrier(unsigned* cnt, unsigned expect) {
    asm volatile("s_waitcnt vmcnt(0)" ::: "memory");
    __syncthreads();
    if (threadIdx.x == 0) {
        __builtin_amdgcn_fence(__ATOMIC_RELEASE, "agent");
        asm volatile("s_waitcnt vmcnt(0)" ::: "memory");
        __hip_atomic_fetch_add(cnt, 1u, __ATOMIC_RELAXED, __HIP_MEMORY_SCOPE_AGENT);
        unsigned sp = 0;
        while (__hip_atomic_load(cnt, __ATOMIC_RELAXED, __HIP_MEMORY_SCOPE_AGENT) < expect) { __builtin_amdgcn_s_sleep(2); if (++sp > (1u << 22)) break; }
        __builtin_amdgcn_fence(__ATOMIC_ACQUIRE, "agent");
        asm volatile("s_waitcnt vmcnt(0)" ::: "memory");
    }
    __syncthreads();
}

__global__ void __launch_bounds__(NWAVES * 64, 2) hymba_fwd(Args a) {
    extern __shared__ __attribute__((aligned(16))) unsigned char lds_raw[];
    LAS unsigned char* lds = (LAS unsigned char*)lds_raw;
    cg::grid_group grid = cg::this_grid();
    volatile LAS unsigned* xst = (volatile LAS unsigned*)(lds + 131072 + 512);
    if (threadIdx.x < 2) xst[threadIdx.x] = 0u;
    __syncthreads();
    const XcdBarrier xbar = xcd_barrier_post((unsigned*)(a.ws + WS_CTL), xst);
#define GRID_SYNC_CG() do { asm volatile("s_waitcnt vmcnt(0)" ::: "memory"); grid.sync(); } while (0)
#define GRID_SYNC() xcd_barrier(xbar)
    const int tid = threadIdx.x, lane = tid & 63, wave = __builtin_amdgcn_readfirstlane(tid >> 6);

    if (a.out == nullptr) GRID_SYNC_CG();
    phase0(lds, a, tid, wave, lane);
    GRID_SYNC();
    phase1(a, wave, lane);
    GRID_SYNC();
    {
        pg8::Gemm g{(const pg8::bf16_t*)(a.ws + WS_H), (const pg8::bf16_t*)(a.ws + WS_WIN), M, NP, D};
        pg8::StaticOrder S; S.init(M, NP, (int)gridDim.x, (int)blockIdx.x);
        pg8::EpiBf16<0> E{(pg8::bf16_t*)(a.ws + WS_PROJ), NP, nullptr, 0, 0, 1.f};
        pg8::gemm_phase<pg8::EpiBf16<0>, pg8::StaticOrder, true, true>(lds, g, S, E);
    }
    GRID_SYNC();
    phase25(a, wave, lane);
    GRID_SYNC();
    rwkv_prepass(lds, a, tid, wave, lane, 0, 64, 256, (int)blockIdx.x);
    GRID_SYNC();
    if (blockIdx.x < 128) {
        f32x4 st[4];
#pragma unroll
        for (int q = 0; q < 4; ++q) st[q] = (f32x4){0.f, 0.f, 0.f, 0.f};
#pragma unroll
        for (int sp = 0; sp < 2; ++sp) {
            int bxo = (int)blockIdx.x; asm volatile("" : "+s"(bxo));
            rwkv_block(lds, a, bxo, 64 * sp, 64 * sp + 64, st, tid, wave, lane);
            GRID_SYNC();
        }
    } else {
        const bf16* P = (const bf16*)(a.ws + WS_PROJ); bf16* mix = (bf16*)(a.ws + WS_H);
        {   int bxo = (int)blockIdx.x - 128; asm volatile("" : "+s"(bxo));
            rwkv_prepass(lds, a, tid, wave, lane, 64, 64, 128, bxo);
            GRID_SYNC(); }
        {   int bxo = (int)blockIdx.x - 128; asm volatile("" : "+s"(bxo));
            attn_phase(lds, P, mix, a.in[8], bxo, 128, 4, tid, wave, lane);
            GRID_SYNC(); }
    }
#pragma unroll
    for (int rr2 = 0; rr2 < 2; ++rr2) {
        pg8::Gemm g{(const pg8::bf16_t*)(a.ws + WS_H), (const pg8::bf16_t*)(a.ws + WS_WOUT), M, D, D};
        pg8::PanelOrder S{rr2, (int)blockIdx.x};
        pg8::EpiRmsRes E{a.in[0], a.out, a.in[5], (const float*)(a.ws + WS_MOD), (unsigned*)(a.ws + WS_XW), (unsigned*)(a.ws + WS_CTL + 16384)};
        pg8::gemm_phase<pg8::EpiRmsRes, pg8::PanelOrder, false, true>(lds, g, S, E);
    }
}

extern "C" void kernel_launch(void* const* d_in, const int* in_sizes, int n_in, void* d_out, int out_size, void* d_ws, size_t ws_size, hipStream_t stream) {
    static int grid = 0;
    if (grid == 0) {
        if (n_in != 19 || out_size != M * D || ws_size < WS_END) { fprintf(stderr, "kernel_launch: unexpected shapes (n_in %d out %d ws %zu)\n", n_in, out_size, ws_size); grid = -1; return; }
        int dev = 0, cus = 0, per_cu = 0;
        (void)hipGetDevice(&dev); (void)hipDeviceGetAttribute(&cus, hipDeviceAttributeMultiprocessorCount, dev);
        (void)hipFuncSetAttribute((const void*)hymba_fwd, hipFuncAttributeMaxDynamicSharedMemorySize, LDS_BYTES);
        (void)hipOccupancyMaxActiveBlocksPerMultiprocessor(&per_cu, (const void*)hymba_fwd, NWAVES * 64, LDS_BYTES);
        (void)hipGetLastError();
        grid = cus > 0 ? cus : 256;
        if (per_cu < 1) fprintf(stderr, "kernel_launch: occupancy query says %d blocks per CU\n", per_cu);
    }
    if (grid < 0) return;
    if (hipMemsetAsync((char*)d_ws + WS_CTL, 0, CTL_BYTES, stream) != hipSuccess) { fprintf(stderr, "kernel_launch: memset of the barrier words failed\n"); return; }
    Args a{};
    for (int i = 0; i < 19; ++i) a.in[i] = (const float*)d_in[i];
    a.out = (float*)d_out; a.ws = (unsigned char*)d_ws;
    void* args[] = {&a};
    hipError_t e = hipLaunchCooperativeKernel((const void*)hymba_fwd, dim3(grid), dim3(NWAVES * 64), args, LDS_BYTES, stream);
    if (e != hipSuccess) fprintf(stderr, "cooperative launch failed: %s (grid %d)\n", hipGetErrorString(e), grid);
}
```

```cpp
#include <hip/hip_runtime.h>
#include <hip/hip_cooperative_groups.h>
#include <cstdio>
#include <cstdint>
namespace cg = cooperative_groups;
namespace pg8 {
#define PG8_LAS __attribute__((address_space(3)))
typedef unsigned short bf16_t;
typedef short bf16x8 __attribute__((ext_vector_type(8)));
typedef float f32x4 __attribute__((ext_vector_type(4)));
typedef unsigned u32x4 __attribute__((ext_vector_type(4)));
constexpr int BM = 256, BK = 64, HALF = 128, HTB = HALF * BK * 2  , STAGE_BYTES = 8 * HTB, NXCD = 8, WGM = 8;

__host__ __device__ __forceinline__ int lds_byte(int r, int c) { const int st = (r >> 4) * 2 + (c >> 5), rr = r & 15, cc = c & 31, ob = rr * 64 + cc * 2; return st * 1024 + (ob ^ (((ob >> 9) & 1) << 5)); }
__host__ __device__ __forceinline__ void stage_rc(int b, int& R, int& C) { const int st = b / 1024, sb = b % 1024, swz = sb ^ (((sb >> 9) & 1) << 5); R = (st >> 1) * 16 + swz / 64; C = (st & 1) * 32 + (swz % 64) / 2; }
__host__ __device__ __forceinline__ int perm32(int rho) { const int n = rho >> 4, i = rho & 15; return 8 * (i >> 2) + 4 * n + (i & 3); }

struct Unit { int pm, pn; };
struct Gemm { const bf16_t* A; const bf16_t* Bt; int M, N, K; };

struct StaticOrder {
    int nM, nN, nwg, G, c;
    __host__ __device__ void init(int M, int N, int G_, int c_) { nM = M / BM; nN = N / BM; nwg = nM * nN; G = G_; c = c_; }
    __host__ __device__ bool next(int i, Unit& u) const {
        const long L = (long)i * G + c; if (L >= nwg) return false;
        int wgid = (int)L; { const int q = nwg / NXCD, r = nwg % NXCD, xcd = wgid % NXCD, off = wgid / NXCD; wgid = (xcd < r ? xcd * (q + 1) : r * (q + 1) + (xcd - r) * q) + off; }
        const int nig = WGM * nN, gid = wgid / nig, fm = gid * WGM, gsz = (nM - fm) < WGM ? (nM - fm) : WGM;
        u.pm = fm + ((wgid % nig) % gsz); u.pn = (wgid % nig) / gsz; return true;
    }
    __device__ __forceinline__ void a_ready(const Unit&) const {}
    __device__ __forceinline__ void done(const Unit&) const {}
};

typedef __bf16 bf16x2n_t __attribute__((ext_vector_type(2))); typedef float f32x2n_t __attribute__((ext_vector_type(2)));
__device__ __forceinline__ unsigned cvt_pk_bf16(float lo, float hi) { const f32x2n_t v = {lo, hi}; return __builtin_bit_cast(unsigned, __builtin_convertvector(v, bf16x2n_t)); }
typedef float f32x2 __attribute__((ext_vector_type(2)));
__device__ __forceinline__ f32x2 gelu_pk(f32x2 v) {
    const f32x2 av = __builtin_elementwise_abs(v), d = av * 0.2316418882f + 1.0f;
    f32x2 t; t.x = __builtin_amdgcn_rcpf(d.x); t.y = __builtin_amdgcn_rcpf(d.y);
    f32x2 q = t * 0.5307027145f + (-0.7265760135f); q = q * t + 0.7107068705f; q = q * t + (-0.142248368f); q = q * t + 0.127414796f; q = q * t;
    const f32x2 s = (v * v) * (-0.72134752044f);
    f32x2 e; e.x = __builtin_amdgcn_exp2f(s.x); e.y = __builtin_amdgcn_exp2f(s.y);
    const f32x2 m = v * (q * e), r = v - m;
    f32x2 o; o.x = v.x < 0.f ? m.x : r.x; o.y = v.y < 0.f ? m.y : r.y; return o;
}

template <int ACT  > struct EpiBf16 {
    static constexpr bool PERM = true, AFTER_DRAIN = false; static_assert(ACT == 0 || ACT == 1, "EpiBf16: ACT is 0 (none) or 1 (gelu_pk)");
    bf16_t* O; int ldc; const float* bias; int split_cols; size_t split_stride; float scale0;
    __device__ __forceinline__ void operator()(const f32x4 (&acc)[2][2][4][2], const Unit& u, int wr, int wc, int fr, int fq) const {
        const int row0 = u.pm * BM + wr * 64 + fr; int colt = u.pn * BM; bf16_t* base = O;
        float sc = 1.f; if (split_cols) { const int t = colt / split_cols; base += (size_t)t * split_stride; colt -= t * split_cols; if (t == 0) sc = scale0; }
        const int col0 = colt + wc * 32 + 8 * fq, bcol0 = u.pn * BM + wc * 32 + 8 * fq;
        f32x4 bv[2][2];
#pragma unroll
        for (int bj = 0; bj < 2; ++bj)
#pragma unroll
            for (int n = 0; n < 2; ++n) bv[bj][n] = bias ? *(const f32x4*)(bias + bcol0 + bj * HALF + 4 * n) : (f32x4){0.f, 0.f, 0.f, 0.f};
#pragma unroll
        for (int ai = 0; ai < 2; ++ai)
#pragma unroll
            for (int m = 0; m < 4; ++m) { bf16_t* rowp = base + (size_t)(row0 + ai * HALF + m * 16) * ldc + col0;
#pragma unroll
                for (int bj = 0; bj < 2; ++bj) { f32x4 v0 = acc[ai][bj][m][0] + bv[bj][0], v1 = acc[ai][bj][m][1] + bv[bj][1];
                    if (ACT == 1) { f32x2 a = gelu_pk((f32x2){v0[0], v0[1]}), b = gelu_pk((f32x2){v0[2], v0[3]}), c = gelu_pk((f32x2){v1[0], v1[1]}), d = gelu_pk((f32x2){v1[2], v1[3]});
                        v0 = (f32x4){a.x, a.y, b.x, b.y}; v1 = (f32x4){c.x, c.y, d.x, d.y}; }
                    v0 = v0 * sc; v1 = v1 * sc; u32x4 w; w.x = cvt_pk_bf16(v0[0], v0[1]); w.y = cvt_pk_bf16(v0[2], v0[3]); w.z = cvt_pk_bf16(v1[0], v1[1]); w.w = cvt_pk_bf16(v1[2], v1[3]);
                    *(u32x4*)(rowp + bj * HALF) = w; } }
    }
};
struct EpiF32 {
    static constexpr bool PERM = false, AFTER_DRAIN = false;
    float* O; int ldc;
    __device__ __forceinline__ void operator()(const f32x4 (&acc)[2][2][4][2], const Unit& u, int wr, int wc, int fr, int fq) const {
        const int col0 = u.pn * BM + wc * 32 + 4 * fq;
#pragma unroll
        for (int ai = 0; ai < 2; ++ai)
#pragma unroll
            for (int m = 0; m < 4; ++m) { float* rowp = O + (size_t)(u.pm * BM + ai * HALF + wr * 64 + m * 16 + fr) * ldc + col0;
#pragma unroll
                for (int bj = 0; bj < 2; ++bj)
#pragma unroll
                    for (int n = 0; n < 2; ++n) *(f32x4*)(rowp + bj * HALF + n * 16) = acc[ai][bj][m][n]; }
    }
};
struct PanelOrder {
    int r, c;
    __device__ __forceinline__ bool next(int i, Unit& u) const { if (i > 0) return false; const int x = c & 7, j = c >> 3; u.pm = 32 * r + 4 * x + (j >> 3); u.pn = j & 7; return true; }
    __device__ __forceinline__ void a_ready(const Unit&) const {}
    __device__ __forceinline__ void done(const Unit&) const {}
};
struct EpiRmsRes {
    static constexpr bool PERM = false, AFTER_DRAIN = true;
    const float* x; float* out; const float* g; const float* mod; unsigned* slots; unsigned* cnt;
    __device__ __forceinline__ void fused(f32x4 (&acc)[2][2][4][2], const Unit& u, int wr, int wc, int fr, int fq, PG8_LAS unsigned char* lds, int wid, int lane) const {
        PG8_LAS float* P = (PG8_LAS float*)lds;
        PG8_LAS float* S = (PG8_LAS float*)(lds + 4096);
        const int tid = wid * 64 + lane;
        const int col0 = u.pn * BM + wc * 32 + 4 * fq;
        f32x4 pre[2][2][2], gg[2][2];
#pragma unroll
        for (int m = 0; m < 2; ++m) { const size_t off = (size_t)(u.pm * BM + wr * 64 + m * 16 + fr) * 2048 + col0;
#pragma unroll
            for (int bj = 0; bj < 2; ++bj)
#pragma unroll
                for (int n = 0; n < 2; ++n) pre[m][bj][n] = *(const f32x4*)(x + off + bj * HALF + n * 16); }
        { const float* gt = mod + (size_t)(u.pm >> 3) * 6144 + 4096;
#pragma unroll
          for (int bj = 0; bj < 2; ++bj)
#pragma unroll
            for (int n = 0; n < 2; ++n) gg[bj][n] = *(const f32x4*)(g + col0 + bj * HALF + n * 16) * *(const f32x4*)(gt + col0 + bj * HALF + n * 16); }
#pragma unroll
        for (int ai = 0; ai < 2; ++ai)
#pragma unroll
            for (int m = 0; m < 4; ++m) { float s = 0.f;
#pragma unroll
                for (int bj = 0; bj < 2; ++bj)
#pragma unroll
                    for (int n = 0; n < 2; ++n) { const f32x4 v = acc[ai][bj][m][n]; s += (v[0] * v[0] + v[1] * v[1]) + (v[2] * v[2] + v[3] * v[3]); }
                s += __shfl_xor(s, 16); s += __shfl_xor(s, 32);
                if (fq == 0) P[(ai * HALF + wr * 64 + m * 16 + fr) * 4 + wc] = s; }
        asm volatile("s_waitcnt lgkmcnt(0)" ::: "memory"); __builtin_amdgcn_s_barrier(); asm volatile("" ::: "memory");
        if (tid < 256) { const f32x4 p = *(const PG8_LAS f32x4*)(P + tid * 4);
            __hip_atomic_store(slots + ((size_t)(u.pm * BM + tid) * 8 + u.pn), __builtin_bit_cast(unsigned, (p[0] + p[1]) + (p[2] + p[3])), __ATOMIC_RELAXED, __HIP_MEMORY_SCOPE_AGENT); }
        asm volatile("s_waitcnt vmcnt(0)" ::: "memory");
        if (lane == 0) __hip_atomic_fetch_add(cnt + 64 * u.pm, 1u, __ATOMIC_RELAXED, __HIP_MEMORY_SCOPE_AGENT);
        if (wid == 0) { unsigned sp = 0;
            while ((unsigned)__builtin_amdgcn_readfirstlane((int)__hip_atomic_load(cnt + 64 * u.pm, __ATOMIC_RELAXED, __HIP_MEMORY_SCOPE_AGENT)) < 64u) { __builtin_amdgcn_s_sleep(2); if (++sp > (1u << 22)) break; }
            __builtin_amdgcn_fence(__ATOMIC_ACQUIRE, "agent"); }
        asm volatile("s_waitcnt vmcnt(0) lgkmcnt(0)" ::: "memory"); __builtin_amdgcn_s_barrier(); asm volatile("" ::: "memory");
        if (tid < 256) { const unsigned* sl = slots + (size_t)(u.pm * BM + tid) * 8; float t = 0.f;
#pragma unroll
            for (int q = 0; q < 8; ++q) t += __builtin_bit_cast(float, __hip_atomic_load(sl + q, __ATOMIC_RELAXED, __HIP_MEMORY_SCOPE_AGENT));
            S[tid] = __builtin_amdgcn_rsqf(t * (1.0f / 2048.0f) + 1e-6f); }
        asm volatile("s_waitcnt lgkmcnt(0)" ::: "memory"); __builtin_amdgcn_s_barrier(); asm volatile("" ::: "memory");
#pragma unroll
        for (int ai = 0; ai < 2; ++ai)
#pragma unroll
            for (int m = 0; m < 4; ++m) { const int r = ai * HALF + wr * 64 + m * 16 + fr; const float rinv = S[r]; const size_t off = (size_t)(u.pm * BM + r) * 2048 + col0;
#pragma unroll
                for (int bj = 0; bj < 2; ++bj)
#pragma unroll
                    for (int n = 0; n < 2; ++n) { const f32x4 xv = (ai == 0 && m < 2) ? pre[m < 2 ? m : 0][bj][n] : *(const f32x4*)(x + off + bj * HALF + n * 16);
                        *(f32x4*)(out + off + bj * HALF + n * 16) = xv + gg[bj][n] * (acc[ai][bj][m][n] * rinv); }
                if (m & 1) asm volatile("" ::: "memory"); }
    }
};
template <class Epi, class Sched, bool ALIGN_EPI = false, bool SP2 = false>
__device__ __forceinline__ void gemm_phase(PG8_LAS unsigned char* lds, const Gemm g, const Sched& S, const Epi& E) {
    const int tid = threadIdx.x, wid = __builtin_amdgcn_readfirstlane(tid >> 6), lane = tid & 63, wr = wid >> 2, wc = wid & 3, fr = lane & 15, fq = lane >> 4;
    const int K = g.K, nt = K / BK;
    unsigned voffA[2], voffB[2];
#pragma unroll
    for (int i = 0; i < 2; ++i) { int R, C; stage_rc(tid * 16 + i * 8192, R, C); const int Rb = Epi::PERM ? ((R & ~31) + perm32(R & 31)) : R;
        voffA[i] = (unsigned)(R * K + C) * 2u; voffB[i] = (unsigned)(Rb * K + C) * 2u; }
    const size_t kstep = (size_t)(BK * 2);
    const size_t hstep = (size_t)HALF * K * 2;
    const size_t tstep = 2 * hstep;
    const unsigned ldsw = (unsigned)wid * 1024u;
    const int aoff = lds_byte(wr * 64 + fr, fq * 8), boff = lds_byte(wc * 32 + fr, fq * 8);
#define PG8_SA(b, h) (((b) * 2 + (h)) * HTB)
#define PG8_SB(b, h) ((4 + (b) * 2 + (h)) * HTB)
#define PG8_STAGE(bufoff, gbase, voff) do { _Pragma("unroll") for (int _i = 0; _i < 2; ++_i) \
        __builtin_amdgcn_global_load_lds((const unsigned*)((const char*)(gbase) + (voff)[_i]), (PG8_LAS unsigned*)(lds + (bufoff) + ldsw + _i * 8192), 16, 0, 0); } while (0)
#define PG8_LDA(dst, b, h) do { _Pragma("unroll") for (int m = 0; m < 4; ++m) _Pragma("unroll") for (int k = 0; k < 2; ++k) dst[m][k] = *(const PG8_LAS bf16x8*)(lds + PG8_SA(b, h) + aoff + m * 2048 + k * 1024); } while (0)
#define PG8_LDB(dst, b, h) do { _Pragma("unroll") for (int n = 0; n < 2; ++n) _Pragma("unroll") for (int k = 0; k < 2; ++k) dst[n][k] = *(const PG8_LAS bf16x8*)(lds + PG8_SB(b, h) + boff + n * 2048 + k * 1024); } while (0)
#define PG8_MMA(ai, bj, At, Bt) do { __builtin_amdgcn_s_setprio(1); _Pragma("unroll") for (int m = 0; m < 4; ++m) _Pragma("unroll") for (int n = 0; n < 2; ++n) _Pragma("unroll") for (int k = 0; k < 2; ++k) \
        acc[ai][bj][m][n] = __builtin_amdgcn_mfma_f32_16x16x32_bf16(Bt[n][k], At[m][k], acc[ai][bj][m][n], 0, 0, 0); __builtin_amdgcn_s_setprio(0); } while (0)
#define PG8_WAIT_V(n) asm volatile("s_waitcnt vmcnt(" #n ")" ::: "memory")
#define PG8_WAIT_L(n) asm volatile("s_waitcnt lgkmcnt(" #n ")" ::: "memory")
#define PG8_BAR __builtin_amdgcn_s_barrier()
#define PG8_SCHED __builtin_amdgcn_sched_barrier(0)
    Unit cur, nxt; int ui = 0;
    if (!S.next(0, cur)) return;
    f32x4 acc[2][2][4][2];
#pragma unroll
    for (int a = 0; a < 2; ++a)
#pragma unroll
        for (int b = 0; b < 2; ++b)
#pragma unroll
            for (int m = 0; m < 4; ++m)
#pragma unroll
                for (int n = 0; n < 2; ++n) acc[a][b][m][n] = (f32x4){0.f, 0.f, 0.f, 0.f};
    bf16x8 At[4][2], B0[2][2], B1[2][2];
    const char* cA = (const char*)g.A + (size_t)cur.pm * tstep; const char* cB = (const char*)g.Bt + (size_t)cur.pn * tstep;
    S.a_ready(cur);
    if constexpr (SP2) {
        PG8_STAGE(PG8_SB(0, 0), cB, voffB); PG8_STAGE(PG8_SB(0, 1), cB + hstep, voffB); PG8_STAGE(PG8_SA(0, 0), cA, voffA); PG8_STAGE(PG8_SA(0, 1), cA + hstep, voffA);
        if (wr == 1) PG8_BAR;
        PG8_WAIT_V(2); PG8_BAR;
        PG8_STAGE(PG8_SB(1, 0), cB + kstep, voffB); PG8_STAGE(PG8_SA(1, 0), cA + kstep, voffA); PG8_STAGE(PG8_SB(1, 1), cB + hstep + kstep, voffB);
        PG8_WAIT_V(6); PG8_BAR;
    } else {
        PG8_STAGE(PG8_SB(0, 0), cB, voffB); PG8_STAGE(PG8_SA(0, 0), cA, voffA); PG8_STAGE(PG8_SB(0, 1), cB + hstep, voffB); PG8_STAGE(PG8_SA(0, 1), cA + hstep, voffA);
        if (wr == 1) PG8_BAR;
        PG8_WAIT_V(4); PG8_BAR;
        PG8_STAGE(PG8_SB(1, 0), cB + kstep, voffB); PG8_STAGE(PG8_SA(1, 0), cA + kstep, voffA); PG8_STAGE(PG8_SB(1, 1), cB + hstep + kstep, voffB);
        PG8_WAIT_V(6); PG8_BAR;
    }
    for (;;) {
        const bool has_next = S.next(ui + 1, nxt);
        const char* nA = has_next ? (const char*)g.A + (size_t)nxt.pm * tstep : cA; const char* nB = has_next ? (const char*)g.Bt + (size_t)nxt.pn * tstep : cB;
        for (int t = 0; t < nt; t += 2) {
            const bool last = (t == nt - 2);
            const char* a1 = cA + (size_t)(t + 1) * kstep;
            const char* a2 = last ? nA : cA + (size_t)(t + 2) * kstep; const char* b2 = last ? nB : cB + (size_t)(t + 2) * kstep;
            const char* a3 = a2 + kstep; const char* b3 = b2 + kstep;
            if (last && has_next) S.a_ready(nxt);
            if constexpr (SP2) {
            PG8_LDB(B0, 0, 0); PG8_LDB(B1, 0, 1); PG8_SCHED; PG8_LDA(At, 0, 0); PG8_STAGE(PG8_SA(1, 1), a1 + hstep, voffA);
            PG8_WAIT_V(8); PG8_WAIT_L(0); PG8_BAR; PG8_MMA(0, 0, At, B0); PG8_MMA(0, 1, At, B1); PG8_BAR; PG8_SCHED;
            PG8_LDA(At, 0, 1); PG8_STAGE(PG8_SB(0, 0), b2, voffB); PG8_STAGE(PG8_SB(0, 1), b2 + hstep, voffB); PG8_STAGE(PG8_SA(0, 0), a2, voffA);
            PG8_WAIT_V(8); PG8_WAIT_L(0); PG8_BAR; PG8_MMA(1, 0, At, B0); PG8_MMA(1, 1, At, B1); PG8_BAR; PG8_SCHED;
            PG8_LDB(B0, 1, 0); PG8_LDB(B1, 1, 1); PG8_SCHED; PG8_LDA(At, 1, 0); PG8_STAGE(PG8_SA(0, 1), a2 + hstep, voffA);
            PG8_WAIT_V(8); PG8_WAIT_L(0); PG8_BAR; PG8_MMA(0, 0, At, B0); PG8_MMA(0, 1, At, B1); PG8_BAR; PG8_SCHED;
            PG8_LDA(At, 1, 1); PG8_STAGE(PG8_SB(1, 0), b3, voffB); PG8_STAGE(PG8_SB(1, 1), b3 + hstep, voffB); PG8_STAGE(PG8_SA(1, 0), a3, voffA);
            PG8_WAIT_V(8); PG8_WAIT_L(0); PG8_BAR; PG8_MMA(1, 0, At, B0); PG8_MMA(1, 1, At, B1); PG8_BAR; PG8_SCHED;
            } else {
            PG8_LDB(B0, 0, 0); PG8_SCHED; PG8_LDA(At, 0, 0); PG8_STAGE(PG8_SA(1, 1), a1 + hstep, voffA);
            PG8_WAIT_L(8); PG8_BAR; PG8_WAIT_L(0); PG8_MMA(0, 0, At, B0); PG8_BAR; PG8_SCHED;
            PG8_LDB(B1, 0, 1); PG8_STAGE(PG8_SB(0, 0), b2, voffB);
            PG8_BAR; PG8_WAIT_L(0); PG8_MMA(0, 1, At, B1); PG8_BAR;
            PG8_LDA(At, 0, 1); PG8_STAGE(PG8_SA(0, 0), a2, voffA);
            PG8_BAR; PG8_WAIT_L(0); PG8_MMA(1, 0, At, B0); PG8_BAR; PG8_SCHED;
            PG8_STAGE(PG8_SB(0, 1), b2 + hstep, voffB);
            PG8_WAIT_V(6); PG8_BAR; PG8_MMA(1, 1, At, B1); PG8_BAR;
            PG8_LDB(B0, 1, 0); PG8_SCHED; PG8_LDA(At, 1, 0); PG8_STAGE(PG8_SA(0, 1), a2 + hstep, voffA);
            PG8_WAIT_L(8); PG8_BAR; PG8_WAIT_L(0); PG8_MMA(0, 0, At, B0); PG8_BAR; PG8_SCHED;
            PG8_LDB(B1, 1, 1); PG8_STAGE(PG8_SB(1, 0), b3, voffB);
            PG8_BAR; PG8_WAIT_L(0); PG8_MMA(0, 1, At, B1); PG8_BAR;
            PG8_LDA(At, 1, 1); PG8_STAGE(PG8_SA(1, 0), a3, voffA);
            PG8_BAR; PG8_WAIT_L(0); PG8_MMA(1, 0, At, B0); PG8_BAR; PG8_SCHED;
            PG8_STAGE(PG8_SB(1, 1), b3 + hstep, voffB);
            PG8_WAIT_V(6); PG8_BAR; PG8_MMA(1, 1, At, B1); PG8_BAR;
            }
        }
        if constexpr (ALIGN_EPI) { if (wr == 0) PG8_BAR; }
        if constexpr (!Epi::AFTER_DRAIN) { E(acc, cur, wr, wc, fr, fq); S.done(cur); }
        if (!has_next) break;
#pragma unroll
        for (int a = 0; a < 2; ++a)
#pragma unroll
            for (int b = 0; b < 2; ++b)
#pragma unroll
                for (int m = 0; m < 4; ++m)
#pragma unroll
                    for (int n = 0; n < 2; ++n) acc[a][b][m][n] = (f32x4){0.f, 0.f, 0.f, 0.f};
        cur = nxt; cA = nA; cB = nB; ++ui;
        if constexpr (ALIGN_EPI) { if (wr == 1) PG8_BAR; }
    }
    PG8_WAIT_V(0);
    if constexpr (!ALIGN_EPI) { if (wr == 0) PG8_BAR; }
    PG8_BAR;
    if constexpr (Epi::AFTER_DRAIN) { E.fused(acc, cur, wr, wc, fr, fq, lds, wid, lane); S.done(cur); }
#undef PG8_SA
#undef PG8_SB
#undef PG8_STAGE
#undef PG8_LDA
#undef PG8_LDB
#undef PG8_MMA
#undef PG8_WAIT_V
#undef PG8_WAIT_L
#undef PG8_BAR
#undef PG8_SCHED
}
}
#define GAS __attribute__((address_space(1)))
#define LAS __attribute__((address_space(3)))
typedef unsigned short bf16;
typedef unsigned v4u __attribute__((ext_vector_type(4)));
typedef unsigned v2u __attribute__((ext_vector_type(2)));
typedef float f32x4 __attribute__((ext_vector_type(4)));
typedef float f32x2 __attribute__((ext_vector_type(2)));
typedef short bf16x8 __attribute__((ext_vector_type(8)));
typedef short s16x4 __attribute__((ext_vector_type(4)));

constexpr int NB = 8, T = 2048, D = 2048, M = NB * T;
constexpr int NIN = 6784, NP = 6912;
constexpr int C_Q = 0, C_K = 1024, C_V = 1280, C_GA = 1536, C_R = 2560, C_RK = 3584, C_RV = 4608, C_WD = 5632, C_AD = 5696, C_GR = 5760;
constexpr size_t MiB = 1u << 20;
constexpr size_t WS_MOD = 0;
constexpr size_t WS_CTL = 512 * 1024, CTL_BYTES = 32768;
constexpr size_t WS_WIN = 2 * MiB;
constexpr size_t WS_WOUT = 29 * MiB;
constexpr size_t WS_H = 40 * MiB;
constexpr size_t WS_PROJ = 104 * MiB;
constexpr size_t WS_MIXOUT = 320 * MiB;
constexpr size_t WS_XW = 2 * MiB;
constexpr size_t WS_XA = 4 * MiB;
constexpr size_t WS_RN = 6 * MiB;
constexpr size_t WS_IMGA = 7 * MiB;
constexpr size_t WS_IMGB = 320 * MiB;
constexpr size_t WS_END = 500 * MiB;
constexpr int LDS_BYTES = 147456, RING_BYTES = 131072;
constexpr int NWAVES = 8;

__device__ __forceinline__ float rcp_f(float v) { return __builtin_amdgcn_rcpf(v); }
#define LDS_WAIT() asm volatile("s_waitcnt lgkmcnt(0)" ::: "memory")
__device__ __forceinline__ unsigned f2bf(float f) { unsigned u = __builtin_bit_cast(unsigned, f); return (u + 0x7fffu + ((u >> 16) & 1u)) >> 16; }
typedef __bf16 bf16x2_t __attribute__((ext_vector_type(2)));
__device__ __forceinline__ unsigned pk2(float lo, float hi) { const f32x2 v = {lo, hi}; return __builtin_bit_cast(unsigned, __builtin_convertvector(v, bf16x2_t)); }
__device__ __forceinline__ float tanh_f(float v) { return 1.f - 2.f * rcp_f(__expf(2.f * v) + 1.f); }
__device__ __forceinline__ float bflo(unsigned u) { return __builtin_bit_cast(float, u << 16); }
__device__ __forceinline__ float bfhi(unsigned u) { return __builtin_bit_cast(float, u & 0xffff0000u); }
__device__ __forceinline__ float silu_f(float v) { return v * rcp_f(1.f + __expf(-v)); }
__device__ __forceinline__ float wave_sum(float v) {
#pragma unroll
    for (int o = 1; o < 64; o <<= 1) v += __shfl_xor(v, o);
    return v;
}
template <int CTRL> __device__ __forceinline__ float dpp_add(float x) {
    const int y = __builtin_amdgcn_update_dpp(0, __builtin_bit_cast(int, x), CTRL, 0xF, 0xF, false);
    return x + __builtin_bit_cast(float, y);
}
__device__ __forceinline__ float reduce16(float x) {
    x = dpp_add<0x128>(x); x = dpp_add<0x124>(x); x = dpp_add<0x122>(x); x = dpp_add<0x121>(x);
    return x;
}
__device__ __forceinline__ float half_sum(float v) {
    v = reduce16(v); v += __shfl_xor(v, 16);
    return v;
}
struct Args { const float* in[19]; float* out; unsigned char* ws; };

__device__ __forceinline__ void p0_transpose_item(const float* W, int K, int N, bf16* WT, LAS float* scr, int item, int lane) {
    const int nblk = N / 32, kb = item / nblk, nb = item % nblk, k0 = 64 * kb, n0 = 32 * nb;
    float wv[32];
#pragma unroll
    for (int i = 0; i < 32; ++i) wv[i] = W[(size_t)(k0 + 2 * i + (lane >> 5)) * N + n0 + (lane & 31)];
#pragma unroll
    for (int i = 0; i < 32; ++i) scr[(2 * i + (lane >> 5)) * 33 + (lane & 31)] = wv[i];
    LDS_WAIT(); asm volatile("" ::: "memory");
    const int c = lane & 7;
#pragma unroll
    for (int j = 0; j < 4; ++j) { const int n = (lane >> 3) + 8 * j; const LAS float* s = scr + (8 * c) * 33 + n;
        v4u o; o.x = pk2(s[0 * 33], s[1 * 33]); o.y = pk2(s[2 * 33], s[3 * 33]); o.z = pk2(s[4 * 33], s[5 * 33]); o.w = pk2(s[6 * 33], s[7 * 33]);
        *(v4u*)(WT + (size_t)(n0 + n) * K + k0 + 8 * c) = o; }
    LDS_WAIT(); asm volatile("" ::: "memory");
}

__device__ __forceinline__ void phase0(LAS unsigned char* lds, const Args& a, int tid, int wave, int lane) {
    const float* c = a.in[1]; const float* w_ada = a.in[2]; const float* b_ada = a.in[3];
    float* mod = (float*)(a.ws + WS_MOD);
    if (blockIdx.x < 192) {
        LAS float* s = (LAS float*)lds;
        LAS float* red = s + 16384;
        for (int i = tid; i < 8 * 2048; i += 512) s[i] = silu_f(c[i]);
        __syncthreads();
        const int j = blockIdx.x, cgp = tid & 7, kp = tid >> 3;
        float acc[8][4];
#pragma unroll
        for (int b = 0; b < 8; ++b)
#pragma unroll
            for (int e = 0; e < 4; ++e) acc[b][e] = 0.f;
#pragma unroll 8
        for (int i = 0; i < 32; ++i) {
            const int k = kp + 64 * i;
            const f32x4 wv = *(const f32x4*)(w_ada + (size_t)k * 6144 + 32 * j + 4 * cgp);
#pragma unroll
            for (int b = 0; b < 8; ++b) { const float sv = s[b * 2048 + k];
#pragma unroll
                for (int e = 0; e < 4; ++e) acc[b][e] += sv * wv[e]; }
        }
#pragma unroll
        for (int b = 0; b < 8; ++b)
#pragma unroll
            for (int e = 0; e < 4; ++e) red[kp * 256 + b * 32 + 4 * cgp + e] = acc[b][e];
        __syncthreads();
        if (tid < 256) {
            float sum = 0.f;
            for (int q = 0; q < 64; ++q) sum += red[q * 256 + tid];
            const int b = tid >> 5, col = tid & 31;
            mod[b * 6144 + 32 * j + col] = sum + b_ada[32 * j + col];
        }
        __syncthreads();
    }
    LAS float* scr = (LAS float*)(lds + wave * 16384);
    const int gw = blockIdx.x * NWAVES + wave, NGW = gridDim.x * NWAVES;
    bf16* WinT = (bf16*)(a.ws + WS_WIN); bf16* WoutT = (bf16*)(a.ws + WS_WOUT);
    constexpr int I_IN = (D / 64) * (NIN / 32), I_OUT = (D / 64) * (D / 32);
    for (int it = gw; it < I_IN + I_OUT; it += NGW) {
        if (it < I_IN) p0_transpose_item(a.in[6], D, NIN, WinT, scr, it, lane);
        else p0_transpose_item(a.in[7], D, D, WoutT, scr, it - I_IN, lane);
    }
    { v4u* z = (v4u*)(WinT + (size_t)NIN * D); const int nz = (NP - NIN) * D * 2 / 16;
      for (int i = blockIdx.x * 512 + tid; i < nz; i += gridDim.x * 512) z[i] = (v4u){0u, 0u, 0u, 0u}; }
}

__device__ __forceinline__ void phase1(const Args& a, int wave, int lane) {
    const float* x = a.in[0]; const float* g = a.in[4];
    const float* mod = (const float*)(a.ws + WS_MOD); bf16* H = (bf16*)(a.ws + WS_H);
    const int gw = blockIdx.x * NWAVES + wave, NGW = gridDim.x * NWAVES;
    for (int m = gw; m < M; m += NGW) {
        const int b = m >> 11;
        const f32x4* xr = (const f32x4*)(x + (size_t)m * D) + lane;
        f32x4 v[8]; float ss = 0.f;
#pragma unroll
        for (int j = 0; j < 8; ++j) { v[j] = xr[64 * j]; ss += (v[j].x * v[j].x + v[j].y * v[j].y) + (v[j].z * v[j].z + v[j].w * v[j].w); }
        const float rinv = rsqrtf(wave_sum(ss) * (1.f / D) + 1e-6f);
        v2u* o8 = (v2u*)(H + (size_t)m * D) + lane;
#pragma unroll
        for (int j = 0; j < 8; ++j) {
            const int col = 4 * lane + 256 * j;
            const f32x4 g4 = *(const f32x4*)(g + col);
            const f32x4 sh = *(const f32x4*)(mod + b * 6144 + col);
            const f32x4 sc = *(const f32x4*)(mod + b * 6144 + 2048 + col);
            const f32x4 o = v[j] * rinv * g4 * (sc + 1.f) + sh;
            v2u w; w.x = pk2(o.x, o.y); w.y = pk2(o.z, o.w);
            o8[64 * j] = w;
        }
    }
}

__device__ __forceinline__ void attn_phase(LAS unsigned char* lds, const bf16* P, bf16* mix, const float* sinks, int u0, int ustride, int nunits, int tid, int wave, int lane) {
    constexpr int KP = 72, VP = 264;
    LAS bf16* Ks = (LAS bf16*)lds;
    LAS bf16* Vt = (LAS bf16*)(lds + 36864);
    const int c = lane & 15, hq = lane >> 4, g = wave >> 1, half = wave & 1;
    v4u kv[4], vv[4];
#define A_LOAD(uu) do { const int b_ = (uu) >> 6, n_ = ((uu) >> 2) & 15, hk_ = (uu) & 3; \
        _Pragma("unroll") for (int i = 0; i < 4; ++i) { const int idx = tid + 512 * i, key = idx >> 3, part = idx & 7, tok = (n_ - 1) * 128 + key; \
            kv[i] = (v4u){0u, 0u, 0u, 0u}; vv[i] = (v4u){0u, 0u, 0u, 0u}; \
            if (tok >= 0) { const size_t row = (size_t)(b_ * T + tok) * NP; kv[i] = *(const v4u*)(P + row + C_K + hk_ * 64 + part * 8); vv[i] = *(const v4u*)(P + row + C_V + hk_ * 64 + part * 8); } } } while (0)
    A_LOAD(u0);
    for (int ui = 0; ui < nunits; ++ui) {
        const int u = u0 + ui * ustride, b = u >> 6, n = (u >> 2) & 15, hk = u & 3, head = hk * 4 + g;
#pragma unroll
        for (int i = 0; i < 4; ++i) { const int idx = tid + 512 * i, key = idx >> 3, part = idx & 7;
            *(LAS v4u*)(Ks + key * KP + part * 8) = kv[i];
#pragma unroll
            for (int e = 0; e < 8; ++e) Vt[(part * 8 + e) * VP + key] = (bf16)((vv[i][e >> 1] >> (16 * (e & 1))) & 0xffffu); }
        __syncthreads();
        if (ui + 1 < nunits) A_LOAD(u + ustride);
        const float sink = sinks[head];
        const size_t rowq = (size_t)(b * T + n * 128 + half * 64 + c);
        bf16x8 qf[2], nqf[2]; v2u ga[4], nga[4];
#pragma unroll
        for (int ks = 0; ks < 2; ++ks) qf[ks] = *(const bf16x8*)(P + rowq * NP + C_Q + head * 64 + 32 * ks + 8 * hq);
#pragma unroll
        for (int dt = 0; dt < 4; ++dt) ga[dt] = *(const v2u*)(P + rowq * NP + C_GA + head * 64 + 16 * dt + 4 * hq);
        for (int ch = 0; ch < 4; ++ch) {
            const int q0 = half * 64 + ch * 16, tb = ((q0 >> 4) >> 1) * 2;
            if (ch + 1 < 4) { const size_t rn = (rowq + 16 * (ch + 1)) * NP;
#pragma unroll
                for (int ks = 0; ks < 2; ++ks) nqf[ks] = *(const bf16x8*)(P + rn + C_Q + head * 64 + 32 * ks + 8 * hq);
#pragma unroll
                for (int dt = 0; dt < 4; ++dt) nga[dt] = *(const v2u*)(P + rn + C_GA + head * 64 + 16 * dt + 4 * hq); }
            f32x4 s[10];
#pragma unroll
            for (int tl = 0; tl < 10; ++tl) {
                f32x4 acc = (f32x4){0.f, 0.f, 0.f, 0.f};
#pragma unroll
                for (int ks = 0; ks < 2; ++ks) { const bf16x8 kf = *(const LAS bf16x8*)(Ks + (16 * (tb + tl) + c) * KP + 32 * ks + 8 * hq);
                    acc = __builtin_amdgcn_mfma_f32_16x16x32_bf16(kf, qf[ks], acc, 0, 0, 0); }
                s[tl] = acc;
            }
            const int qi = q0 + c;
            float mx = sink;
#pragma unroll
            for (int tl = 0; tl < 10; ++tl)
#pragma unroll
                for (int r = 0; r < 4; ++r) { const int si = 16 * (tb + tl) + 4 * hq + r;
                    const bool valid = (si > qi) && (si <= qi + 128) && (n > 0 || si >= 128);
                    const float sv = valid ? s[tl][r] * 0.125f : -1e30f; s[tl][r] = sv; mx = fmaxf(mx, sv); }
            mx = fmaxf(mx, __shfl_xor(mx, 16)); mx = fmaxf(mx, __shfl_xor(mx, 32));
            float sum = 0.f;
#pragma unroll
            for (int tl = 0; tl < 10; ++tl)
#pragma unroll
                for (int r = 0; r < 4; ++r) { const float p = __expf(s[tl][r] - mx); s[tl][r] = p; sum += p; }
            sum += __shfl_xor(sum, 16); sum += __shfl_xor(sum, 32);
            const float inv = rcp_f(sum + __expf(sink - mx));
            f32x4 o[4];
#pragma unroll
            for (int dt = 0; dt < 4; ++dt) o[dt] = (f32x4){0.f, 0.f, 0.f, 0.f};
#pragma unroll
            for (int kp = 0; kp < 5; ++kp) {
                v4u pw; pw.x = pk2(s[2 * kp][0], s[2 * kp][1]); pw.y = pk2(s[2 * kp][2], s[2 * kp][3]); pw.z = pk2(s[2 * kp + 1][0], s[2 * kp + 1][1]); pw.w = pk2(s[2 * kp + 1][2], s[2 * kp + 1][3]);
                const bf16x8 pf = __builtin_bit_cast(bf16x8, pw);
#pragma unroll
                for (int dt = 0; dt < 4; ++dt) {
                    const v2u v0 = *(const LAS v2u*)(Vt + (16 * dt + c) * VP + 16 * (tb + 2 * kp) + 4 * hq);
                    const v2u v1 = *(const LAS v2u*)(Vt + (16 * dt + c) * VP + 16 * (tb + 2 * kp + 1) + 4 * hq);
                    v4u vw; vw.x = v0.x; vw.y = v0.y; vw.z = v1.x; vw.w = v1.y;
                    o[dt] = __builtin_amdgcn_mfma_f32_16x16x32_bf16(__builtin_bit_cast(bf16x8, vw), pf, o[dt], 0, 0, 0);
                }
            }
            bf16* orow = mix + (rowq + 16 * ch) * D + head * 64 + 4 * hq;
#pragma unroll
            for (int dt = 0; dt < 4; ++dt) {
                const float g0 = bflo(ga[dt].x), g1 = bfhi(ga[dt].x), g2 = bflo(ga[dt].y), g3 = bfhi(ga[dt].y);
                v2u w; w.x = pk2(o[dt][0] * inv * silu_f(g0), o[dt][1] * inv * silu_f(g1)); w.y = pk2(o[dt][2] * inv * silu_f(g2), o[dt][3] * inv * silu_f(g3));
                *(v2u*)(orow + 16 * dt) = w;
            }
#pragma unroll
            for (int ks = 0; ks < 2; ++ks) qf[ks] = nqf[ks];
#pragma unroll
            for (int dt = 0; dt < 4; ++dt) ga[dt] = nga[dt];
        }
        __syncthreads();
    }
#undef A_LOAD
}

#define XB_TMO      128
#define XB_XCNT(j)  (256  + 64 * (j))
#define XB_XSUB(j)  (1280 + 64 * (j))
#define XB_XGEN(j)  (2304 + 64 * (j))
#define XB_TOP      3328
#define XB_TOPGEN   3392
#define XCD_BAR_WORDS 3456
#define XB_SPIN_CAP (1u << 18)

__device__ __forceinline__ unsigned xb_ld(unsigned* p)              { return __hip_atomic_load(p, __ATOMIC_RELAXED, __HIP_MEMORY_SCOPE_AGENT); }
__device__ __forceinline__ unsigned xb_add(unsigned* p, unsigned v) { return __hip_atomic_fetch_add(p, v, __ATOMIC_RELAXED, __HIP_MEMORY_SCOPE_AGENT); }
__device__ __forceinline__ unsigned xb_xcc_id() { return (unsigned)__builtin_amdgcn_s_getreg((3 << 11) | 20) & 0xFu; }
#define XB_SPIN(cond, bar) do { unsigned _sp = 0; while (cond) { __builtin_amdgcn_s_sleep(1); \
    if ((++_sp & 255u) == 0u) { if (xb_ld(&(bar)[XB_TMO])) break; if (_sp > XB_SPIN_CAP) { atomicAdd(&(bar)[XB_TMO], 1u); break; } } } } while (0)

struct XcdBarrier {
    unsigned* bar; unsigned x;
    volatile LAS unsigned* st;
};

__device__ __forceinline__ XcdBarrier xcd_barrier_post(unsigned* bar, volatile LAS unsigned* st) {
    XcdBarrier b; b.bar = bar; b.x = xb_xcc_id(); b.st = st;
    if (threadIdx.x == 0) (void)xb_add(&bar[XB_XCNT(b.x)], 1u);
    return b;
}
__device__ __forceinline__ void xcd_barrier_complete(unsigned* bar, unsigned x, unsigned& nloc, unsigned& nx) {
    const unsigned G = gridDim.x * gridDim.y * gridDim.z;
    unsigned sum, cnt, mine, sp = 0u;
    for (;;) {
        sum = 0u; cnt = 0u; mine = 0u;
#pragma unroll
        for (unsigned j = 0; j < 16; ++j) { const unsigned c = xb_ld(&bar[XB_XCNT(j)]); sum += c; cnt += (c > 0u) ? 1u : 0u; mine = (j == x) ? c : mine; }
        if (sum == G) break;
        __builtin_amdgcn_s_sleep(1);
        if ((++sp & 255u) == 0u) { if (xb_ld(&bar[XB_TMO])) break; if (sp > XB_SPIN_CAP) { atomicAdd(&bar[XB_TMO], 1u); break; } }
    }
    nloc = mine > 0u ? mine : 1u; nx = cnt > 0u ? cnt : 1u;
}

__device__ __forceinline__ void xcd_barrier(const XcdBarrier& b) {
    asm volatile("s_waitcnt vmcnt(0)" ::: "memory");
    __syncthreads();
    if (threadIdx.x == 0) {
        unsigned* bar = b.bar;
        __builtin_amdgcn_s_waitcnt(0);
        unsigned nloc = b.st[0], nx = b.st[1];
        if (nloc == 0u) { xcd_barrier_complete(bar, b.x, nloc, nx); b.st[0] = nloc; b.st[1] = nx; }
        const unsigned old = xb_add(&bar[XB_XSUB(b.x)], 1u);
        const unsigned gen = old / nloc;
        if (old + 1u == (gen + 1u) * nloc) {
            __builtin_amdgcn_fence(__ATOMIC_RELEASE, "agent");
            asm volatile("s_waitcnt vmcnt(0)" ::: "memory");
            const unsigned og = xb_add(&bar[XB_TOP], 1u);
            const unsigned tg = og / nx;
            if (og + 1u == (tg + 1u) * nx) xb_add(&bar[XB_TOPGEN], 1u);
            else XB_SPIN(xb_ld(&bar[XB_TOPGEN]) == tg, bar);
            __builtin_amdgcn_fence(__ATOMIC_ACQUIRE, "agent");
            xb_add(&bar[XB_XGEN(b.x)], 1u);
            asm volatile("s_waitcnt vmcnt(0)" ::: "memory");
        } else {
            XB_SPIN(xb_ld(&bar[XB_XGEN(b.x)]) == gen, bar);
            __builtin_amdgcn_fence(__ATOMIC_ACQUIRE, "agent");
            asm volatile("s_waitcnt vmcnt(0)" ::: "memory");
        }
    }
    __syncthreads();
}
__device__ __forceinline__ void phase25(const Args& a, int wave, int lane) {
    const bf16* P = (const bf16*)(a.ws + WS_PROJ);
    bf16* XW = (bf16*)(a.ws + WS_XW); bf16* XA = (bf16*)(a.ws + WS_XA); float* RN = (float*)(a.ws + WS_RN);
    const float* mu = a.in[9]; const float* k_k = a.in[14];
    const float mu_w = mu[3072 + lane], mu_a = mu[3136 + lane];
    float muk[16], kkc[16];
#pragma unroll
    for (int j = 0; j < 16; ++j) { muk[j] = mu[1024 + lane * 16 + j]; kkc[j] = k_k[lane * 16 + j]; }
    const int gw = blockIdx.x * NWAVES + wave, NGW = gridDim.x * NWAVES;
    for (int m = gw; m < M; m += NGW) {
        const bool first = (m & (T - 1)) == 0;
        const bf16* pr = P + (size_t)m * NP;
        const float wc = bflo((unsigned)pr[C_WD + lane]), ac = bflo((unsigned)pr[C_AD + lane]);
        const float wp = first ? 0.f : bflo((unsigned)pr[C_WD + lane - NP]), ap = first ? 0.f : bflo((unsigned)pr[C_AD + lane - NP]);
        XW[(size_t)m * 64 + lane] = (bf16)f2bf(tanh_f(wc + (wp - wc) * mu_w));
        XA[(size_t)m * 64 + lane] = (bf16)f2bf(ac + (ap - ac) * mu_a);
        v4u kc[2], kp[2];
#pragma unroll
        for (int h = 0; h < 2; ++h) { kc[h] = *(const v4u*)(pr + C_RK + lane * 16 + 8 * h);
            kp[h] = first ? (v4u){0u, 0u, 0u, 0u} : *(const v4u*)(pr - NP + C_RK + lane * 16 + 8 * h); }
        float ssq = 0.f;
#pragma unroll
        for (int h = 0; h < 2; ++h)
#pragma unroll
            for (int j = 0; j < 4; ++j) {
                const float c0 = bflo(kc[h][j]), c1 = bfhi(kc[h][j]), p0 = bflo(kp[h][j]), p1 = bfhi(kp[h][j]);
                const float k0 = (c0 + (p0 - c0) * muk[8 * h + 2 * j]) * kkc[8 * h + 2 * j], k1 = (c1 + (p1 - c1) * muk[8 * h + 2 * j + 1]) * kkc[8 * h + 2 * j + 1];
                ssq += k0 * k0 + k1 * k1; }
        ssq = dpp_add<0xB1>(ssq); ssq = dpp_add<0x4E>(ssq);
        if ((lane & 3) == 0) RN[(size_t)m * 16 + (lane >> 2)] = rsqrtf(fmaxf(ssq, 1e-24f));
    }
}

constexpr int TC = 16, NCH = T / TC;
constexpr int IMG = 12864, I_PA = 0, I_A2 = 4096, I_V = 8192, I_DE = 12288, I_SC = 12544, I_BON = 12800;
constexpr int STG = 14144, P_SC = 12864, P_BON = 13888;
#define WG_BAR() do { asm volatile("s_waitcnt lgkmcnt(0)" ::: "memory"); __builtin_amdgcn_s_barrier(); asm volatile("" ::: "memory"); } while (0)
__device__ __forceinline__ unsigned char* img_ptr(unsigned char* ws, int chain, int chunk) {
    return chain < 14 ? ws + WS_IMGA + ((size_t)chain * NCH + chunk) * IMG : ws + WS_IMGB + ((size_t)(chain - 14) * NCH + chunk) * IMG;
}

__device__ __forceinline__ void rwkv_prepass(LAS unsigned char* lds, const Args& a, int tid, int wave, int lane, int cb, int nch, int G, int bidx) {
    const bf16* P = (const bf16*)(a.ws + WS_PROJ);
    const bf16* XW = (const bf16*)(a.ws + WS_XW); const bf16* XA = (const bf16*)(a.ws + WS_XA); const float* RN = (const float*)(a.ws + WS_RN);
    const int g = wave >> 2, hw = wave & 3, grp = bidx * 2 + g, gpc = G >> 6, ntask = nch / gpc, chain = grp / gpc, c0 = cb + (grp % gpc) * ntask;
    const int b = chain >> 4; const unsigned hh = chain & 15, rowbase = (unsigned)b * T;
    const unsigned cc = lane & 15, hq = lane >> 4; const int ch = 16 * hw + (int)cc; const unsigned col = hh * 64 + ch; const int tg = tid & 255;
    const float* mu = a.in[9];
    const float cw0 = a.in[10][col], ca0 = a.in[12][col], ckk = a.in[14][col], cka = a.in[15][col], crk = a.in[16][col];
    const float mur = mu[col], muk = mu[1024 + col], muv = mu[2048 + col];
    bf16x8 bwf[2], baf[2];
#pragma unroll
    for (int ks = 0; ks < 2; ++ks) {
        float tw[8], ta[8];
#pragma unroll
        for (int j = 0; j < 8; ++j) { const size_t o = (size_t)(32 * ks + 8 * hq + j) * 1024 + col; tw[j] = a.in[11][o]; ta[j] = a.in[13][o]; }
        v4u w; w.x = pk2(tw[0], tw[1]); w.y = pk2(tw[2], tw[3]); w.z = pk2(tw[4], tw[5]); w.w = pk2(tw[6], tw[7]); bwf[ks] = __builtin_bit_cast(bf16x8, w);
        v4u v; v.x = pk2(ta[0], ta[1]); v.y = pk2(ta[2], ta[3]); v.z = pk2(ta[4], ta[5]); v.w = pk2(ta[6], ta[7]); baf[ks] = __builtin_bit_cast(bf16x8, v);
    }
    const int pa_w = (hw >> 1) * 256 + (cc >> 2) * 16 + ((hw & 1) * 4 + (cc & 3)) * 2;
    v4u n_aw[2], n_aa[2], c_aw[2], c_aa[2], m_aw[2], m_aa[2];
    unsigned n_rc[4], n_kc[4], n_vc[4], n_rp, n_kp, n_vp, c_rc[4], c_kc[4], c_vc[4], c_rp, c_kp, c_vp, m_rc[4], m_kc[4], m_vc[4], m_rp, m_kp, m_vp;
    float n_rn[4], c_rn[4], m_rn[4];
#define H_LOAD(k) do { const unsigned t0_ = (unsigned)(k) * TC; const unsigned ra_ = (rowbase + t0_ + cc) * 64u + 8u * hq; \
        _Pragma("unroll") for (int ks = 0; ks < 2; ++ks) { n_aw[ks] = *(const v4u*)(XW + (ra_ + 32u * ks)); n_aa[ks] = *(const v4u*)(XA + (ra_ + 32u * ks)); } \
        const unsigned tb_ = t0_ + 4u * hq, pe_ = (rowbase + tb_) * (unsigned)NP + col; \
        _Pragma("unroll") for (int r = 0; r < 4; ++r) { n_rc[r] = P[pe_ + (unsigned)(r * NP + C_R)]; n_kc[r] = P[pe_ + (unsigned)(r * NP + C_RK)]; n_vc[r] = P[pe_ + (unsigned)(r * NP + C_RV)]; \
            n_rn[r] = RN[(rowbase + tb_ + r) * 16u + hh]; } \
        if (tb_ > 0u) { n_rp = P[pe_ - (unsigned)(NP - C_R)]; n_kp = P[pe_ - (unsigned)(NP - C_RK)]; n_vp = P[pe_ - (unsigned)(NP - C_RV)]; } else { n_rp = 0u; n_kp = 0u; n_vp = 0u; } \
    } while (0)
#define H_ADV() do { _Pragma("unroll") for (int ks = 0; ks < 2; ++ks) { c_aw[ks] = m_aw[ks]; c_aa[ks] = m_aa[ks]; m_aw[ks] = n_aw[ks]; m_aa[ks] = n_aa[ks]; } \
        _Pragma("unroll") for (int r = 0; r < 4; ++r) { c_rc[r] = m_rc[r]; c_kc[r] = m_kc[r]; c_vc[r] = m_vc[r]; c_rn[r] = m_rn[r]; m_rc[r] = n_rc[r]; m_kc[r] = n_kc[r]; m_vc[r] = n_vc[r]; m_rn[r] = n_rn[r]; } \
        c_rp = m_rp; c_kp = m_kp; c_vp = m_vp; m_rp = n_rp; m_kp = n_kp; m_vp = n_vp; } while (0)
    H_LOAD(c0); H_ADV(); H_LOAD(c0 + 1);
    for (int k = 0; k < ntask; ++k) {
        LAS unsigned char* B_ = lds + (g * 2 + (k & 1)) * STG;
        H_ADV();
        if (k + 2 < ntask) H_LOAD(c0 + k + 2);
        f32x4 accw = (f32x4){0.f, 0.f, 0.f, 0.f}, acca = (f32x4){0.f, 0.f, 0.f, 0.f};
#pragma unroll
        for (int ks = 0; ks < 2; ++ks) { accw = __builtin_amdgcn_mfma_f32_16x16x32_bf16(__builtin_bit_cast(bf16x8, c_aw[ks]), bwf[ks], accw, 0, 0, 0);
            acca = __builtin_amdgcn_mfma_f32_16x16x32_bf16(__builtin_bit_cast(bf16x8, c_aa[ks]), baf[ks], acca, 0, 0, 0); }
        float dec_[4], rr_[4], vx_[4], kkn_[4], k2_[4], bv_[4], pbo_[4], psc_[2][8];
#pragma unroll
        for (int r = 0; r < 4; ++r) {
            const float rcu = bflo(c_rc[r]), kcu = bflo(c_kc[r]), vcu = bflo(c_vc[r]);
            const float rpv = bflo(r == 0 ? c_rp : c_rc[r > 0 ? r - 1 : 0]), kpv = bflo(r == 0 ? c_kp : c_kc[r > 0 ? r - 1 : 0]), vpv = bflo(r == 0 ? c_vp : c_vc[r > 0 ? r - 1 : 0]);
            const float rr = rcu + (rpv - rcu) * mur, kx = kcu + (kpv - kcu) * muk; vx_[r] = vcu + (vpv - vcu) * muv;
            dec_[r] = __expf(-0.60653066f * rcp_f(1.f + __expf(-(cw0 + accw[r]))));
            const float ic = rcp_f(1.f + __expf(-(ca0 + acca[r])));
            const float kkn = kx * ckk * c_rn[r], k2 = kx * (1.f + (ic - 1.f) * cka), bv = kkn * ic;
            rr_[r] = rr; kkn_[r] = kkn; k2_[r] = k2; bv_[r] = bv;
            pbo_[r] = reduce16(rr * k2 * crk); }
#pragma unroll
        for (int pl = 0; pl < 2; ++pl) { const int r0 = 2 * pl, r1 = r0 + 1; const float wr1 = dec_[r1] * rr_[r1];
            psc_[pl][0] = reduce16(bv_[r0] * rr_[r0]); psc_[pl][1] = reduce16(k2_[r0] * rr_[r0]);
            psc_[pl][2] = reduce16(-bv_[r0] * kkn_[r1]); psc_[pl][3] = reduce16(-k2_[r0] * kkn_[r1]);
            psc_[pl][4] = reduce16(bv_[r0] * wr1); psc_[pl][5] = reduce16(k2_[r0] * wr1);
            psc_[pl][6] = reduce16(bv_[r1] * rr_[r1]); psc_[pl][7] = reduce16(k2_[r1] * rr_[r1]); }
        if (cc == 0) {
#pragma unroll
            for (int r = 0; r < 4; ++r) *(LAS float*)(B_ + P_BON + ((4 * hq + r) * 4 + hw) * 4) = pbo_[r];
#pragma unroll
            for (int pl = 0; pl < 2; ++pl)
#pragma unroll
                for (int e = 0; e < 8; ++e) *(LAS float*)(B_ + P_SC + (((2 * hq + pl) * 8 + e) * 4 + hw) * 4) = psc_[pl][e]; }
        { float D_[4], Dp_[4]; const float p0 = dec_[0], p1 = p0 * dec_[1], p2 = p1 * dec_[2], p3 = p2 * dec_[3];
          const float g0 = __shfl(p3, cc), g1 = __shfl(p3, cc + 16), g2 = __shfl(p3, cc + 32);
          const float E_ = hq == 0 ? 1.f : (hq == 1 ? g0 : (hq == 2 ? g0 * g1 : g0 * g1 * g2));
          D_[0] = E_ * p0; D_[1] = E_ * p1; D_[2] = E_ * p2; D_[3] = E_ * p3; Dp_[0] = E_; Dp_[1] = D_[0]; Dp_[2] = D_[1]; Dp_[3] = D_[2];
#pragma unroll
          for (int r = 0; r < 4; ++r) { const int pr_ = 2 * hq + (r >> 1), od = r & 1; const float rcp = rcp_f(D_[r]);
            const unsigned pw_ = pk2(-kkn_[r] * Dp_[r], D_[r] * rr_[r]);
            *(LAS bf16*)(B_ + I_PA + pr_ * 512 + od * 128 + pa_w) = (bf16)(pw_ & 0xffffu); *(LAS bf16*)(B_ + I_PA + pr_ * 512 + od * 128 + 64 + pa_w) = (bf16)(pw_ >> 16);
            *(LAS unsigned*)(B_ + I_A2 + (pr_ * 64 + ch) * 8 + od * 4) = pk2(bv_[r] * rcp, k2_[r] * rcp); *(LAS float*)(B_ + I_V + (pr_ * 64 + ch) * 8 + od * 4) = vx_[r]; }
          if (hq == 3) *(LAS float*)(B_ + I_DE + ch * 4) = D_[3]; }
        WG_BAR();
        unsigned char* gi = img_ptr(a.ws, chain, c0 + k);
#pragma unroll
        for (int i = 0; i < 3; ++i) *(v4u*)(gi + (tg + 256 * i) * 16) = *(const LAS v4u*)(B_ + (tg + 256 * i) * 16);
        if (tg < 16) *(v4u*)(gi + I_DE + tg * 16) = *(const LAS v4u*)(B_ + I_DE + tg * 16);
        else if (tg < 36) { const int j_ = tg - 16;
            const LAS unsigned char* pp_ = B_ + (j_ < 16 ? P_SC + j_ * 64 : P_BON + (j_ - 16) * 64);
            f32x4 o_;
#pragma unroll
            for (int e = 0; e < 4; ++e) { const f32x4 q_ = *(const LAS f32x4*)(pp_ + e * 16); o_[e] = (q_[0] + q_[1]) + (q_[2] + q_[3]); }
            *(f32x4*)(gi + (j_ < 16 ? I_SC + j_ * 16 : I_BON + (j_ - 16) * 16)) = o_; }
    }
    WG_BAR();
#undef H_LOAD
#undef H_ADV
}

constexpr int O_Y = 3 * IMG;
__device__ __forceinline__ void rwkv_block(LAS unsigned char* lds, const Args& a, int chain, int cbeg, int cend, f32x4 (&st)[4], int tid, int wave, int lane) {
    const int b = chain >> 4, hh = chain & 15, rowbase = b * T;
    if (wave < 4) {
        const int i = lane & 15, hq = lane >> 4, n = 16 * wave + i;
        const unsigned hmask = hq == 0 ? 0xffffffffu : 0u;
        const int pa_off = (i & 3) * 64 + hq * 16;
        const f32x4 zero4 = (f32x4){0.f, 0.f, 0.f, 0.f};
        WG_BAR();
        __builtin_amdgcn_s_setprio(3);
        int bi = 0;
        for (int c = cbeg; c < cend; ++c) {
            LAS unsigned char* B = lds + bi * IMG;
            LAS unsigned char* Yb = lds + O_Y + (c & 1) * 4096;
            const float scv = *(const LAS float*)(B + I_SC + lane * 4);
            bf16x8 pa0 = *(const LAS bf16x8*)(B + I_PA + pa_off), pa1 = *(const LAS bf16x8*)(B + I_PA + 256 + pa_off);
            f32x2 v2 = *(const LAS f32x2*)(B + I_V + n * 8);
            v2u a2[4];
#pragma unroll
            for (int q = 0; q < 4; ++q) a2[q] = *(const LAS v2u*)(B + I_A2 + (16 * q + i) * 8);
#pragma unroll
            for (int pp = 0; pp < TC / 2; ++pp) {
                bf16x8 npa0 = pa0, npa1 = pa1; f32x2 nv2 = v2; v2u na2[4];
#pragma unroll
                for (int q = 0; q < 4; ++q) na2[q] = a2[q];
                if (pp + 1 < TC / 2) {
                    npa0 = *(const LAS bf16x8*)(B + I_PA + ((pp + 1) * 2 + 0) * 256 + pa_off); npa1 = *(const LAS bf16x8*)(B + I_PA + ((pp + 1) * 2 + 1) * 256 + pa_off);
                    nv2 = *(const LAS f32x2*)(B + I_V + ((pp + 1) * 64 + n) * 8);
#pragma unroll
                    for (int q = 0; q < 4; ++q) na2[q] = *(const LAS v2u*)(B + I_A2 + ((pp + 1) * 64 + 16 * q + i) * 8);
                }
                __builtin_amdgcn_sched_barrier(0);
                v4u s0, s1;
                s0.x = pk2(st[0][0], st[0][1]); s0.y = pk2(st[0][2], st[0][3]); s0.z = pk2(st[1][0], st[1][1]); s0.w = pk2(st[1][2], st[1][3]);
                s1.x = pk2(st[2][0], st[2][1]); s1.y = pk2(st[2][2], st[2][3]); s1.z = pk2(st[3][0], st[3][1]); s1.w = pk2(st[3][2], st[3][3]);
                const f32x4 d0 = __builtin_amdgcn_mfma_f32_16x16x32_bf16(pa0, __builtin_bit_cast(bf16x8, s0), zero4, 0, 0, 0);
                const f32x4 d1 = __builtin_amdgcn_mfma_f32_16x16x32_bf16(pa1, __builtin_bit_cast(bf16x8, s1), zero4, 0, 0, 0);
                const f32x4 d = d0 + d1;
                float sc[8];
#pragma unroll
                for (int e = 0; e < 8; ++e) sc[e] = __builtin_bit_cast(float, __builtin_amdgcn_readlane(__builtin_bit_cast(int, scv), pp * 8 + e));
                const float sa0 = d[0];
                const float sa1 = d[2] + sa0 * sc[2] + v2[0] * sc[3];
                *(LAS float*)(Yb + ((2 * pp) * 64 + n) * 4) = d[1] + sa0 * sc[0] + v2[0] * sc[1];
                *(LAS float*)(Yb + ((2 * pp + 1) * 64 + n) * 4) = (d[3] + sa0 * sc[4] + v2[0] * sc[5]) + (sa1 * sc[6] + v2[1] * sc[7]);
                v2u bw; bw.x = pk2(sa0, v2[0]) & hmask; bw.y = pk2(sa1, v2[1]) & hmask;
                const s16x4 bfr = __builtin_bit_cast(s16x4, bw);
#pragma unroll
                for (int q = 0; q < 4; ++q) st[q] = __builtin_amdgcn_mfma_f32_16x16x16bf16_1k(__builtin_bit_cast(s16x4, a2[q]), bfr, st[q], 0, 0, 0);
                pa0 = npa0; pa1 = npa1; v2 = nv2;
#pragma unroll
                for (int q = 0; q < 4; ++q) a2[q] = na2[q];
            }
#pragma unroll
            for (int q = 0; q < 4; ++q) st[q] = st[q] * *(const LAS f32x4*)(B + I_DE + (16 * q + 4 * hq) * 4);
            bi = bi == 2 ? 0 : bi + 1;
            WG_BAR();
        }
        __builtin_amdgcn_s_setprio(0);
    } else {
        const bf16* P = (const bf16*)(a.ws + WS_PROJ); bf16* mix = (bf16*)(a.ws + WS_H);
        const int hw = wave - 4, cc = lane & 15, hq = lane >> 4, ch = 16 * hw + cc, col = hh * 64 + ch, tg = tid - 256;
        const float clw = a.in[17][col], clb = a.in[18][col];
        const unsigned char* ibase = img_ptr(a.ws, chain, 0);
        const bf16x8 ones8 = __builtin_bit_cast(bf16x8, (v4u){0x3f803f80u, 0x3f803f80u, 0x3f803f80u, 0x3f803f80u});
        v4u imA[3], itA = (v4u){0u, 0u, 0u, 0u}, imB[3], itB = (v4u){0u, 0u, 0u, 0u}; unsigned gE[4] = {0u, 0u, 0u, 0u}, gO[4] = {0u, 0u, 0u, 0u};
#define I_LOAD(im, it, k) do { const unsigned go_ = (unsigned)((k) * IMG); \
        _Pragma("unroll") for (int i_ = 0; i_ < 3; ++i_) im[i_] = *(const v4u*)(ibase + (go_ + (unsigned)((tg + 256 * i_) * 16))); \
        if (tg < 36) it = *(const v4u*)(ibase + (go_ + (unsigned)(I_DE + tg * 16))); } while (0)
#define I_STORE(im, it, bix) do { LAS unsigned char* B_ = lds + (bix) * IMG; \
        _Pragma("unroll") for (int i_ = 0; i_ < 3; ++i_) *(LAS v4u*)(B_ + (tg + 256 * i_) * 16) = im[i_]; \
        if (tg < 36) *(LAS v4u*)(B_ + I_DE + tg * 16) = it; } while (0)
#define H_GLOAD(gx, k) do { const unsigned pg_ = (unsigned)((rowbase + (k) * TC + 4 * hq) * NP + C_GR + col); \
        _Pragma("unroll") for (int r = 0; r < 4; ++r) gx[r] = P[pg_ + (unsigned)(r * NP)]; } while (0)
#define H_POST(gx, k, bix) do { LAS unsigned char* B_ = lds + (bix) * IMG; LAS unsigned char* Y_ = lds + O_Y + ((k) & 1) * 4096; \
          \
        f32x4 s1_ = (f32x4){0.f, 0.f, 0.f, 0.f}, s2_ = (f32x4){0.f, 0.f, 0.f, 0.f}; \
        _Pragma("unroll") for (int kb = 0; kb < 2; ++kb) { \
            const f32x4 ya = *(const LAS f32x4*)(Y_ + (cc * 64 + 32 * kb + 8 * hq) * 4), yb = *(const LAS f32x4*)(Y_ + (cc * 64 + 32 * kb + 8 * hq + 4) * 4); \
            v4u f1, f2; f1.x = pk2(ya[0], ya[1]); f1.y = pk2(ya[2], ya[3]); f1.z = pk2(yb[0], yb[1]); f1.w = pk2(yb[2], yb[3]); \
            f2.x = pk2(ya[0] * ya[0], ya[1] * ya[1]); f2.y = pk2(ya[2] * ya[2], ya[3] * ya[3]); f2.z = pk2(yb[0] * yb[0], yb[1] * yb[1]); f2.w = pk2(yb[2] * yb[2], yb[3] * yb[3]); \
            s1_ = __builtin_amdgcn_mfma_f32_16x16x32_bf16(__builtin_bit_cast(bf16x8, f1), ones8, s1_, 0, 0, 0); \
            s2_ = __builtin_amdgcn_mfma_f32_16x16x32_bf16(__builtin_bit_cast(bf16x8, f2), ones8, s2_, 0, 0, 0); } \
        _Pragma("unroll") for (int r = 0; r < 4; ++r) { const int t_ = 4 * hq + r; \
            const float yo = *(const LAS float*)(Y_ + (t_ * 64 + ch) * 4), vv = *(const LAS float*)(B_ + I_V + ((t_ >> 1) * 64 + ch) * 8 + (t_ & 1) * 4), bon = *(const LAS float*)(B_ + I_BON + t_ * 4); \
            const float mean = s1_[r] * (1.f / 64.f), var = fmaxf(s2_[r] * (1.f / 64.f) - mean * mean, 0.f), rs = rsqrtf(var + 64e-5f); \
            const float o_ = ((yo - mean) * rs * clw + clb + bon * vv) * silu_f(bflo(gx[r])); \
            mix[(unsigned)((rowbase + (k) * TC + t_) * D + 1024 + col)] = (bf16)(pk2(o_, o_) & 0xffffu); } \
    } while (0)
        I_LOAD(imA, itA, cbeg); I_STORE(imA, itA, 0);
        I_LOAD(imA, itA, cbeg + 1); I_LOAD(imB, itB, cbeg + 2);
        H_GLOAD(gE, cbeg);
        WG_BAR();
        int bi = 0;
        for (int c = cbeg; c < cend; c += 2) {
            {
                const int bn = bi == 2 ? 0 : bi + 1, bp = bi == 0 ? 2 : bi - 1;
                I_STORE(imA, itA, bn); if (c + 3 < cend) I_LOAD(imA, itA, c + 3);
                if (c > cbeg) H_POST(gO, c - 1, bp);
                H_GLOAD(gO, c + 1);
                bi = bn;
                WG_BAR();
            }
            {
                const int bn = bi == 2 ? 0 : bi + 1, bp = bi == 0 ? 2 : bi - 1;
                if (c + 2 < cend) { I_STORE(imB, itB, bn); if (c + 4 < cend) I_LOAD(imB, itB, c + 4); }
                H_POST(gE, c, bp);
                if (c + 2 < cend) H_GLOAD(gE, c + 2);
                bi = bn;
                WG_BAR();
            }
        }
        H_POST(gO, cend - 1, (bi == 0 ? 2 : bi - 1));
#undef I_LOAD
#undef I_STORE
#undef H_GLOAD
#undef H_POST
    }
    WG_BAR();
}

__device__ __forceinline__ void phase5(const Args& a, int wave, int lane) {
    const float* x = a.in[0]; const float* g = a.in[5];
    const float* mod = (const float*)(a.ws + WS_MOD); const bf16* MO = (const bf16*)(a.ws + WS_MIXOUT);
    const int gw = blockIdx.x * NWAVES + wave, NGW = gridDim.x * NWAVES;
    for (int m = gw; m < M; m += NGW) {
        const int b = m >> 11;
        const v4u* mr = (const v4u*)(MO + (size_t)m * D) + lane;
        const f32x4* xr = (const f32x4*)(x + (size_t)m * D);
        v4u mv[4]; f32x4 xv[8]; float ss = 0.f;
#pragma unroll
        for (int j = 0; j < 4; ++j) mv[j] = mr[64 * j];
#pragma unroll
        for (int j = 0; j < 4; ++j) { xv[2 * j] = xr[128 * j + 2 * lane]; xv[2 * j + 1] = xr[128 * j + 2 * lane + 1]; }
#pragma unroll
        for (int j = 0; j < 4; ++j)
#pragma unroll
            for (int e = 0; e < 4; ++e) { const float lo = bflo(mv[j][e]), hi = bfhi(mv[j][e]); ss += lo * lo + hi * hi; }
        const float rinv = rsqrtf(wave_sum(ss) * (1.f / D) + 1e-6f);
        f32x4* orow = (f32x4*)(a.out + (size_t)m * D);
#pragma unroll
        for (int j = 0; j < 4; ++j)
#pragma unroll
            for (int h = 0; h < 2; ++h) {
                const int col = 512 * j + 8 * lane + 4 * h;
                const f32x4 g4 = *(const f32x4*)(g + col);
                const f32x4 gt = *(const f32x4*)(mod + b * 6144 + 4096 + col);
                const f32x4 v = (f32x4){bflo(mv[j][2 * h]), bfhi(mv[j][2 * h]), bflo(mv[j][2 * h + 1]), bfhi(mv[j][2 * h + 1])};
                orow[128 * j + 2 * lane + h] = xv[2 * j + h] + gt * (v * rinv * g4);
            }
    }
}

__device__ __forceinline__ void sub_barrier(unsigned* cnt, unsigned expect) {
    asm volatile("s_waitcnt vmcnt(0)" ::: "memory");
    __syncthreads();
    if (threadIdx.x == 0) {
        __builtin_amdgcn_fence(__ATOMIC_RELEASE, "agent");
        asm volatile("s_waitcnt vmcnt(0)" ::: "memory");
        __hip_atomic_fetch_add(cnt, 1u, __ATOMIC_RELAXED, __HIP_MEMORY_SCOPE_AGENT);
        unsigned sp = 0;
        while (__hip_atomic_load(cnt, __ATOMIC_RELAXED, __HIP_MEMORY_SCOPE_AGENT) < expect) { __builtin_amdgcn_s_sleep(2); if (++sp > (1u << 22)) break; }
        __builtin_amdgcn_fence(__ATOMIC_ACQUIRE, "agent");
        asm volatile("s_waitcnt vmcnt(0)" ::: "memory");
    }
    __syncthreads();
}

__global__ void __launch_bounds__(NWAVES * 64, 2) hymba_fwd(Args a) {
    extern __shared__ __attribute__((aligned(16))) unsigned char lds_raw[];
    LAS unsigned char* lds = (LAS unsigned char*)lds_raw;
    cg::grid_group grid = cg::this_grid();
    volatile LAS unsigned* xst = (volatile LAS unsigned*)(lds + 131072 + 512);
    if (threadIdx.x < 2) xst[threadIdx.x] = 0u;
    __syncthreads();
    const XcdBarrier xbar = xcd_barrier_post((unsigned*)(a.ws + WS_CTL), xst);
#define GRID_SYNC_CG() do { asm volatile("s_waitcnt vmcnt(0)" ::: "memory"); grid.sync(); } while (0)
#define GRID_SYNC() xcd_barrier(xbar)
    const int tid = threadIdx.x, lane = tid & 63, wave = __builtin_amdgcn_readfirstlane(tid >> 6);

    if (a.out == nullptr) GRID_SYNC_CG();
    phase0(lds, a, tid, wave, lane);
    GRID_SYNC();
    phase1(a, wave, lane);
    GRID_SYNC();
    {
        pg8::Gemm g{(const pg8::bf16_t*)(a.ws + WS_H), (const pg8::bf16_t*)(a.ws + WS_WIN), M, NP, D};
        pg8::StaticOrder S; S.init(M, NP, (int)gridDim.x, (int)blockIdx.x);
        pg8::EpiBf16<0> E{(pg8::bf16_t*)(a.ws + WS_PROJ), NP, nullptr, 0, 0, 1.f};
        pg8::gemm_phase<pg8::EpiBf16<0>, pg8::StaticOrder, true, true>(lds, g, S, E);
    }
    GRID_SYNC();
    phase25(a, wave, lane);
    GRID_SYNC();
    rwkv_prepass(lds, a, tid, wave, lane, 0, 64, 256, (int)blockIdx.x);
    GRID_SYNC();
    if (blockIdx.x < 128) {
        f32x4 st[4];
#pragma unroll
        for (int q = 0; q < 4; ++q) st[q] = (f32x4){0.f, 0.f, 0.f, 0.f};
#pragma unroll
        for (int sp = 0; sp < 2; ++sp) {
            int bxo = (int)blockIdx.x; asm volatile("" : "+s"(bxo));
            rwkv_block(lds, a, bxo, 64 * sp, 64 * sp + 64, st, tid, wave, lane);
            GRID_SYNC();
        }
    } else {
        const bf16* P = (const bf16*)(a.ws + WS_PROJ); bf16* mix = (bf16*)(a.ws + WS_H);
        {   int bxo = (int)blockIdx.x - 128; asm volatile("" : "+s"(bxo));
            rwkv_prepass(lds, a, tid, wave, lane, 64, 64, 128, bxo);
            GRID_SYNC(); }
        {   int bxo = (int)blockIdx.x - 128; asm volatile("" : "+s"(bxo));
            attn_phase(lds, P, mix, a.in[8], bxo, 128, 4, tid, wave, lane);
            GRID_SYNC(); }
    }
#pragma unroll
    for (int rr2 = 0; rr2 < 2; ++rr2) {
        pg8::Gemm g{(const pg8::bf16_t*)(a.ws + WS_H), (const pg8::bf16_t*)(a.ws + WS_WOUT), M, D, D};
        pg8::PanelOrder S{rr2, (int)blockIdx.x};
        pg8::EpiRmsRes E{a.in[0], a.out, a.in[5], (const float*)(a.ws + WS_MOD), (unsigned*)(a.ws + WS_XW), (unsigned*)(a.ws + WS_CTL + 16384)};
        pg8::gemm_phase<pg8::EpiRmsRes, pg8::PanelOrder, false, true>(lds, g, S, E);
    }
}

extern "C" void kernel_launch(void* const* d_in, const int* in_sizes, int n_in, void* d_out, int out_size, void* d_ws, size_t ws_size, hipStream_t stream) {
    static int grid = 0;
    if (grid == 0) {
        if (n_in != 19 || out_size != M * D || ws_size < WS_END) { fprintf(stderr, "kernel_launch: unexpected shapes (n_in %d out %d ws %zu)\n", n_in, out_size, ws_size); grid = -1; return; }
        int dev = 0, cus = 0, per_cu = 0;
        (void)hipGetDevice(&dev); (void)hipDeviceGetAttribute(&cus, hipDeviceAttributeMultiprocessorCount, dev);
        (void)hipFuncSetAttribute((const void*)hymba_fwd, hipFuncAttributeMaxDynamicSharedMemorySize, LDS_BYTES);
        (void)hipOccupancyMaxActiveBlocksPerMultiprocessor(&per_cu, (const void*)hymba_fwd, NWAVES * 64, LDS_BYTES);
        (void)hipGetLastError();
        grid = cus > 0 ? cus : 256;
        if (per_cu < 1) fprintf(stderr, "kernel_launch: occupancy query says %d blocks per CU\n", per_cu);
    }
    if (grid < 0) return;
    if (hipMemsetAsync((char*)d_ws + WS_CTL, 0, CTL_BYTES, stream) != hipSuccess) { fprintf(stderr, "kernel_launch: memset of the barrier words failed\n"); return; }
    Args a{};
    for (int i = 0; i < 19; ++i) a.in[i] = (const float*)d_in[i];
    a.out = (float*)d_out; a.ws = (unsigned char*)d_ws;
    void* args[] = {&a};
    hipError_t e = hipLaunchCooperativeKernel((const void*)hymba_fwd, dim3(grid), dim3(NWAVES * 64), args, LDS_BYTES, stream);
    if (e != hipSuccess) fprintf(stderr, "cooperative launch failed: %s (grid %d)\n", hipGetErrorString(e), grid);
}
```

```cpp
#include <hip/hip_runtime.h>
#include <hip/hip_cooperative_groups.h>
#include <cstdio>
#include <cstdint>
namespace cg = cooperative_groups;
namespace pg8 {
#define PG8_LAS __attribute__((address_space(3)))
typedef unsigned short bf16_t;
typedef short bf16x8 __attribute__((ext_vector_type(8)));
typedef float f32x4 __attribute__((ext_vector_type(4)));
typedef unsigned u32x4 __attribute__((ext_vector_type(4)));
constexpr int BM = 256, BK = 64, HALF = 128, HTB = HALF * BK * 2  , STAGE_BYTES = 8 * HTB, NXCD = 8, WGM = 8;

__host__ __device__ __forceinline__ int lds_byte(int r, int c) { const int st = (r >> 4) * 2 + (c >> 5), rr = r & 15, cc = c & 31, ob = rr * 64 + cc * 2; return st * 1024 + (ob ^ (((ob >> 9) & 1) << 5)); }
__host__ __device__ __forceinline__ void stage_rc(int b, int& R, int& C) { const int st = b / 1024, sb = b % 1024, swz = sb ^ (((sb >> 9) & 1) << 5); R = (st >> 1) * 16 + swz / 64; C = (st & 1) * 32 + (swz % 64) / 2; }
__host__ __device__ __forceinline__ int perm32(int rho) { const int n = rho >> 4, i = rho & 15; return 8 * (i >> 2) + 4 * n + (i & 3); }

struct Unit { int pm, pn; };
struct Gemm { const bf16_t* A; const bf16_t* Bt; int M, N, K; };

struct StaticOrder {
    int nM, nN, nwg, G, c;
    __host__ __device__ void init(int M, int N, int G_, int c_) { nM = M / BM; nN = N / BM; nwg = nM * nN; G = G_; c = c_; }
    __host__ __device__ bool next(int i, Unit& u) const {
        const long L = (long)i * G + c; if (L >= nwg) return false;
        int wgid = (int)L; { const int q = nwg / NXCD, r = nwg % NXCD, xcd = wgid % NXCD, off = wgid / NXCD; wgid = (xcd < r ? xcd * (q + 1) : r * (q + 1) + (xcd - r) * q) + off; }
        const int nig = WGM * nN, gid = wgid / nig, fm = gid * WGM, gsz = (nM - fm) < WGM ? (nM - fm) : WGM;
        u.pm = fm + ((wgid % nig) % gsz); u.pn = (wgid % nig) / gsz; return true;
    }
    __device__ __forceinline__ void a_ready(const Unit&) const {}
    __device__ __forceinline__ void done(const Unit&) const {}
};

typedef __bf16 bf16x2n_t __attribute__((ext_vector_type(2))); typedef float f32x2n_t __attribute__((ext_vector_type(2)));
__device__ __forceinline__ unsigned cvt_pk_bf16(float lo, float hi) { const f32x2n_t v = {lo, hi}; return __builtin_bit_cast(unsigned, __builtin_convertvector(v, bf16x2n_t)); }
typedef float f32x2 __attribute__((ext_vector_type(2)));
__device__ __forceinline__ f32x2 gelu_pk(f32x2 v) {
    const f32x2 av = __builtin_elementwise_abs(v), d = av * 0.2316418882f + 1.0f;
    f32x2 t; t.x = __builtin_amdgcn_rcpf(d.x); t.y = __builtin_amdgcn_rcpf(d.y);
    f32x2 q = t * 0.5307027145f + (-0.7265760135f); q = q * t + 0.7107068705f; q = q * t + (-0.142248368f); q = q * t + 0.127414796f; q = q * t;
    const f32x2 s = (v * v) * (-0.72134752044f);
    f32x2 e; e.x = __builtin_amdgcn_exp2f(s.x); e.y = __builtin_amdgcn_exp2f(s.y);
    const f32x2 m = v * (q * e), r = v - m;
    f32x2 o; o.x = v.x < 0.f ? m.x : r.x; o.y = v.y < 0.f ? m.y : r.y; return o;
}

template <int ACT  > struct EpiBf16 {
    static constexpr bool PERM = true, AFTER_DRAIN = false; static_assert(ACT == 0 || ACT == 1, "EpiBf16: ACT is 0 (none) or 1 (gelu_pk)");
    bf16_t* O; int ldc; const float* bias; int split_cols; size_t split_stride; float scale0;
    __device__ __forceinline__ void operator()(const f32x4 (&acc)[2][2][4][2], const Unit& u, int wr, int wc, int fr, int fq) const {
        const int row0 = u.pm * BM + wr * 64 + fr; int colt = u.pn * BM; bf16_t* base = O;
        float sc = 1.f; if (split_cols) { const int t = colt / split_cols; base += (size_t)t * split_stride; colt -= t * split_cols; if (t == 0) sc = scale0; }
        const int col0 = colt + wc * 32 + 8 * fq, bcol0 = u.pn * BM + wc * 32 + 8 * fq;
        f32x4 bv[2][2];
#pragma unroll
        for (int bj = 0; bj < 2; ++bj)
#pragma unroll
            for (int n = 0; n < 2; ++n) bv[bj][n] = bias ? *(const f32x4*)(bias + bcol0 + bj * HALF + 4 * n) : (f32x4){0.f, 0.f, 0.f, 0.f};
#pragma unroll
        for (int ai = 0; ai < 2; ++ai)
#pragma unroll
            for (int m = 0; m < 4; ++m) { bf16_t* rowp = base + (size_t)(row0 + ai * HALF + m * 16) * ldc + col0;
#pragma unroll
                for (int bj = 0; bj < 2; ++bj) { f32x4 v0 = acc[ai][bj][m][0] + bv[bj][0], v1 = acc[ai][bj][m][1] + bv[bj][1];
                    if (ACT == 1) { f32x2 a = gelu_pk((f32x2){v0[0], v0[1]}), b = gelu_pk((f32x2){v0[2], v0[3]}), c = gelu_pk((f32x2){v1[0], v1[1]}), d = gelu_pk((f32x2){v1[2], v1[3]});
                        v0 = (f32x4){a.x, a.y, b.x, b.y}; v1 = (f32x4){c.x, c.y, d.x, d.y}; }
                    v0 = v0 * sc; v1 = v1 * sc; u32x4 w; w.x = cvt_pk_bf16(v0[0], v0[1]); w.y = cvt_pk_bf16(v0[2], v0[3]); w.z = cvt_pk_bf16(v1[0], v1[1]); w.w = cvt_pk_bf16(v1[2], v1[3]);
                    *(u32x4*)(rowp + bj * HALF) = w; } }
    }
};
struct EpiF32 {
    static constexpr bool PERM = false, AFTER_DRAIN = false;
    float* O; int ldc;
    __device__ __forceinline__ void operator()(const f32x4 (&acc)[2][2][4][2], const Unit& u, int wr, int wc, int fr, int fq) const {
        const int col0 = u.pn * BM + wc * 32 + 4 * fq;
#pragma unroll
        for (int ai = 0; ai < 2; ++ai)
#pragma unroll
            for (int m = 0; m < 4; ++m) { float* rowp = O + (size_t)(u.pm * BM + ai * HALF + wr * 64 + m * 16 + fr) * ldc + col0;
#pragma unroll
                for (int bj = 0; bj < 2; ++bj)
#pragma unroll
                    for (int n = 0; n < 2; ++n) *(f32x4*)(rowp + bj * HALF + n * 16) = acc[ai][bj][m][n]; }
    }
};
struct PanelOrder {
    int r, c;
    __device__ __forceinline__ bool next(int i, Unit& u) const { if (i > 0) return false; const int x = c & 7, j = c >> 3; u.pm = 32 * r + 4 * x + (j >> 3); u.pn = j & 7; return true; }
    __device__ __forceinline__ void a_ready(const Unit&) const {}
    __device__ __forceinline__ void done(const Unit&) const {}
};
struct EpiRmsRes {
    static constexpr bool PERM = false, AFTER_DRAIN = true;
    const float* x; float* out; const float* g; const float* mod; unsigned* slots; unsigned* cnt;
    __device__ __forceinline__ void fused(f32x4 (&acc)[2][2][4][2], const Unit& u, int wr, int wc, int fr, int fq, PG8_LAS unsigned char* lds, int wid, int lane) const {
        PG8_LAS float* P = (PG8_LAS float*)lds;
        PG8_LAS float* S = (PG8_LAS float*)(lds + 4096);
        const int tid = wid * 64 + lane;
        const int col0 = u.pn * BM + wc * 32 + 4 * fq;
        f32x4 pre[2][2][2], gg[2][2];
#pragma unroll
        for (int m = 0; m < 2; ++m) { const size_t off = (size_t)(u.pm * BM + wr * 64 + m * 16 + fr) * 2048 + col0;
#pragma unroll
            for (int bj = 0; bj < 2; ++bj)
#pragma unroll
                for (int n = 0; n < 2; ++n) pre[m][bj][n] = *(const f32x4*)(x + off + bj * HALF + n * 16); }
        { const float* gt = mod + (size_t)(u.pm >> 3) * 6144 + 4096;
#pragma unroll
          for (int bj = 0; bj < 2; ++bj)
#pragma unroll
            for (int n = 0; n < 2; ++n) gg[bj][n] = *(const f32x4*)(g + col0 + bj * HALF + n * 16) * *(const f32x4*)(gt + col0 + bj * HALF + n * 16); }
#pragma unroll
        for (int ai = 0; ai < 2; ++ai)
#pragma unroll
            for (int m = 0; m < 4; ++m) { float s = 0.f;
#pragma unroll
                for (int bj = 0; bj < 2; ++bj)
#pragma unroll
                    for (int n = 0; n < 2; ++n) { const f32x4 v = acc[ai][bj][m][n]; s += (v[0] * v[0] + v[1] * v[1]) + (v[2] * v[2] + v[3] * v[3]); }
                s += __shfl_xor(s, 16); s += __shfl_xor(s, 32);
                if (fq == 0) P[(ai * HALF + wr * 64 + m * 16 + fr) * 4 + wc] = s; }
        asm volatile("s_waitcnt lgkmcnt(0)" ::: "memory"); __builtin_amdgcn_s_barrier(); asm volatile("" ::: "memory");
        if (tid < 256) { const f32x4 p = *(const PG8_LAS f32x4*)(P + tid * 4);
            __hip_atomic_store(slots + ((size_t)(u.pm * BM + tid) * 8 + u.pn), __builtin_bit_cast(unsigned, (p[0] + p[1]) + (p[2] + p[3])), __ATOMIC_RELAXED, __HIP_MEMORY_SCOPE_AGENT); }
        asm volatile("s_waitcnt vmcnt(0)" ::: "memory");
        if (lane == 0) __hip_atomic_fetch_add(cnt + 64 * u.pm, 1u, __ATOMIC_RELAXED, __HIP_MEMORY_SCOPE_AGENT);
        if (wid == 0) { unsigned sp = 0;
            while ((unsigned)__builtin_amdgcn_readfirstlane((int)__hip_atomic_load(cnt + 64 * u.pm, __ATOMIC_RELAXED, __HIP_MEMORY_SCOPE_AGENT)) < 64u) { __builtin_amdgcn_s_sleep(2); if (++sp > (1u << 22)) break; }
            __builtin_amdgcn_fence(__ATOMIC_ACQUIRE, "agent"); }
        asm volatile("s_waitcnt vmcnt(0) lgkmcnt(0)" ::: "memory"); __builtin_amdgcn_s_barrier(); asm volatile("" ::: "memory");
        if (tid < 256) { const unsigned* sl = slots + (size_t)(u.pm * BM + tid) * 8; float t = 0.f;
#pragma unroll
            for (int q = 0; q < 8; ++q) t += __builtin_bit_cast(float, __hip_atomic_load(sl + q, __ATOMIC_RELAXED, __HIP_MEMORY_SCOPE_AGENT));
            S[tid] = __builtin_amdgcn_rsqf(t * (1.0f / 2048.0f) + 1e-6f); }
        asm volatile("s_waitcnt lgkmcnt(0)" ::: "memory"); __builtin_amdgcn_s_barrier(); asm volatile("" ::: "memory");
#pragma unroll
        for (int ai = 0; ai < 2; ++ai)
#pragma unroll
            for (int m = 0; m < 4; ++m) { const int r = ai * HALF + wr * 64 + m * 16 + fr; const float rinv = S[r]; const size_t off = (size_t)(u.pm * BM + r) * 2048 + col0;
#pragma unroll
                for (int bj = 0; bj < 2; ++bj)
#pragma unroll
                    for (int n = 0; n < 2; ++n) { const f32x4 xv = (ai == 0 && m < 2) ? pre[m < 2 ? m : 0][bj][n] : *(const f32x4*)(x + off + bj * HALF + n * 16);
                        *(f32x4*)(out + off + bj * HALF + n * 16) = xv + gg[bj][n] * (acc[ai][bj][m][n] * rinv); }
                if (m & 1) asm volatile("" ::: "memory"); }
    }
};
template <class Epi, class Sched, bool ALIGN_EPI = false, bool SP2 = false>
__device__ __forceinline__ void gemm_phase(PG8_LAS unsigned char* lds, const Gemm g, const Sched& S, const Epi& E) {
    const int tid = threadIdx.x, wid = __builtin_amdgcn_readfirstlane(tid >> 6), lane = tid & 63, wr = wid >> 2, wc = wid & 3, fr = lane & 15, fq = lane >> 4;
    const int K = g.K, nt = K / BK;
    unsigned voffA[2], voffB[2];
#pragma unroll
    for (int i = 0; i < 2; ++i) { int R, C; stage_rc(tid * 16 + i * 8192, R, C); const int Rb = Epi::PERM ? ((R & ~31) + perm32(R & 31)) : R;
        voffA[i] = (unsigned)(R * K + C) * 2u; voffB[i] = (unsigned)(Rb * K + C) * 2u; }
    const size_t kstep = (size_t)(BK * 2);
    const size_t hstep = (size_t)HALF * K * 2;
    const size_t tstep = 2 * hstep;
    const unsigned ldsw = (unsigned)wid * 1024u;
    const int aoff = lds_byte(wr * 64 + fr, fq * 8), boff = lds_byte(wc * 32 + fr, fq * 8);
#define PG8_SA(b, h) (((b) * 2 + (h)) * HTB)
#define PG8_SB(b, h) ((4 + (b) * 2 + (h)) * HTB)
#define PG8_STAGE(bufoff, gbase, voff) do { _Pragma("unroll") for (int _i = 0; _i < 2; ++_i) \
        __builtin_amdgcn_global_load_lds((const unsigned*)((const char*)(gbase) + (voff)[_i]), (PG8_LAS unsigned*)(lds + (bufoff) + ldsw + _i * 8192), 16, 0, 0); } while (0)
#define PG8_LDA(dst, b, h) do { _Pragma("unroll") for (int m = 0; m < 4; ++m) _Pragma("unroll") for (int k = 0; k < 2; ++k) dst[m][k] = *(const PG8_LAS bf16x8*)(lds + PG8_SA(b, h) + aoff + m * 2048 + k * 1024); } while (0)
#define PG8_LDB(dst, b, h) do { _Pragma("unroll") for (int n = 0; n < 2; ++n) _Pragma("unroll") for (int k = 0; k < 2; ++k) dst[n][k] = *(const PG8_LAS bf16x8*)(lds + PG8_SB(b, h) + boff + n * 2048 + k * 1024); } while (0)
#define PG8_MMA(ai, bj, At, Bt) do { __builtin_amdgcn_s_setprio(1); _Pragma("unroll") for (int m = 0; m < 4; ++m) _Pragma("unroll") for (int n = 0; n < 2; ++n) _Pragma("unroll") for (int k = 0; k < 2; ++k) \
        acc[ai][bj][m][n] = __builtin_amdgcn_mfma_f32_16x16x32_bf16(Bt[n][k], At[m][k], acc[ai][bj][m][n], 0, 0, 0); __builtin_amdgcn_s_setprio(0); } while (0)
#define PG8_WAIT_V(n) asm volatile("s_waitcnt vmcnt(" #n ")" ::: "memory")
#define PG8_WAIT_L(n) asm volatile("s_waitcnt lgkmcnt(" #n ")" ::: "memory")
#define PG8_BAR __builtin_amdgcn_s_barrier()
#define PG8_SCHED __builtin_amdgcn_sched_barrier(0)
    Unit cur, nxt; int ui = 0;
    if (!S.next(0, cur)) return;
    f32x4 acc[2][2][4][2];
#pragma unroll
    for (int a = 0; a < 2; ++a)
#pragma unroll
        for (int b = 0; b < 2; ++b)
#pragma unroll
            for (int m = 0; m < 4; ++m)
#pragma unroll
                for (int n = 0; n < 2; ++n) acc[a][b][m][n] = (f32x4){0.f, 0.f, 0.f, 0.f};
    bf16x8 At[4][2], B0[2][2], B1[2][2];
    const char* cA = (const char*)g.A + (size_t)cur.pm * tstep; const char* cB = (const char*)g.Bt + (size_t)cur.pn * tstep;
    S.a_ready(cur);
    if constexpr (SP2) {
        PG8_STAGE(PG8_SB(0, 0), cB, voffB); PG8_STAGE(PG8_SB(0, 1), cB + hstep, voffB); PG8_STAGE(PG8_SA(0, 0), cA, voffA); PG8_STAGE(PG8_SA(0, 1), cA + hstep, voffA);
        if (wr == 1) PG8_BAR;
        PG8_WAIT_V(2); PG8_BAR;
        PG8_STAGE(PG8_SB(1, 0), cB + kstep, voffB); PG8_STAGE(PG8_SA(1, 0), cA + kstep, voffA); PG8_STAGE(PG8_SB(1, 1), cB + hstep + kstep, voffB);
        PG8_WAIT_V(6); PG8_BAR;
    } else {
        PG8_STAGE(PG8_SB(0, 0), cB, voffB); PG8_STAGE(PG8_SA(0, 0), cA, voffA); PG8_STAGE(PG8_SB(0, 1), cB + hstep, voffB); PG8_STAGE(PG8_SA(0, 1), cA + hstep, voffA);
        if (wr == 1) PG8_BAR;
        PG8_WAIT_V(4); PG8_BAR;
        PG8_STAGE(PG8_SB(1, 0), cB + kstep, voffB); PG8_STAGE(PG8_SA(1, 0), cA + kstep, voffA); PG8_STAGE(PG8_SB(1, 1), cB + hstep + kstep, voffB);
        PG8_WAIT_V(6); PG8_BAR;
    }
    for (;;) {
        const bool has_next = S.next(ui + 1, nxt);
        const char* nA = has_next ? (const char*)g.A + (size_t)nxt.pm * tstep : cA; const char* nB = has_next ? (const char*)g.Bt + (size_t)nxt.pn * tstep : cB;
        for (int t = 0; t < nt; t += 2) {
            const bool last = (t == nt - 2);
            const char* a1 = cA + (size_t)(t + 1) * kstep;
            const char* a2 = last ? nA : cA + (size_t)(t + 2) * kstep; const char* b2 = last ? nB : cB + (size_t)(t + 2) * kstep;
            const char* a3 = a2 + kstep; const char* b3 = b2 + kstep;
            if (last && has_next) S.a_ready(nxt);
            if constexpr (SP2) {
            PG8_LDB(B0, 0, 0); PG8_LDB(B1, 0, 1); PG8_SCHED; PG8_LDA(At, 0, 0); PG8_STAGE(PG8_SA(1, 1), a1 + hstep, voffA);
            PG8_WAIT_V(8); PG8_WAIT_L(0); PG8_BAR; PG8_MMA(0, 0, At, B0); PG8_MMA(0, 1, At, B1); PG8_BAR; PG8_SCHED;
            PG8_LDA(At, 0, 1); PG8_STAGE(PG8_SB(0, 0), b2, voffB); PG8_STAGE(PG8_SB(0, 1), b2 + hstep, voffB); PG8_STAGE(PG8_SA(0, 0), a2, voffA);
            PG8_WAIT_V(8); PG8_WAIT_L(0); PG8_BAR; PG8_MMA(1, 0, At, B0); PG8_MMA(1, 1, At, B1); PG8_BAR; PG8_SCHED;
            PG8_LDB(B0, 1, 0); PG8_LDB(B1, 1, 1); PG8_SCHED; PG8_LDA(At, 1, 0); PG8_STAGE(PG8_SA(0, 1), a2 + hstep, voffA);
            PG8_WAIT_V(8); PG8_WAIT_L(0); PG8_BAR; PG8_MMA(0, 0, At, B0); PG8_MMA(0, 1, At, B1); PG8_BAR; PG8_SCHED;
            PG8_LDA(At, 1, 1); PG8_STAGE(PG8_SB(1, 0), b3, voffB); PG8_STAGE(PG8_SB(1, 1), b3 + hstep, voffB); PG8_STAGE(PG8_SA(1, 0), a3, voffA);
            PG8_WAIT_V(8); PG8_WAIT_L(0); PG8_BAR; PG8_MMA(1, 0, At, B0); PG8_MMA(1, 1, At, B1); PG8_BAR; PG8_SCHED;
            } else {
            PG8_LDB(B0, 0, 0); PG8_SCHED; PG8_LDA(At, 0, 0); PG8_STAGE(PG8_SA(1, 1), a1 + hstep, voffA);
            PG8_WAIT_L(8); PG8_BAR; PG8_WAIT_L(0); PG8_MMA(0, 0, At, B0); PG8_BAR; PG8_SCHED;
            PG8_LDB(B1, 0, 1); PG8_STAGE(PG8_SB(0, 0), b2, voffB);
            PG8_BAR; PG8_WAIT_L(0); PG8_MMA(0, 1, At, B1); PG8_BAR;
            PG8_LDA(At, 0, 1); PG8_STAGE(PG8_SA(0, 0), a2, voffA);
            PG8_BAR; PG8_WAIT_L(0); PG8_MMA(1, 0, At, B0); PG8_BAR; PG8_SCHED;
            PG8_STAGE(PG8_SB(0, 1), b2 + hstep, voffB);
            PG8_WAIT_V(6); PG8_BAR; PG8_MMA(1, 1, At, B1); PG8_BAR;
            PG8_LDB(B0, 1, 0); PG8_SCHED; PG8_LDA(At, 1, 0); PG8_STAGE(PG8_SA(0, 1), a2 + hstep, voffA);
            PG8_WAIT_L(8); PG8_BAR; PG8_WAIT_L(0); PG8_MMA(0, 0, At, B0); PG8_BAR; PG8_SCHED;
            PG8_LDB(B1, 1, 1); PG8_STAGE(PG8_SB(1, 0), b3, voffB);
            PG8_BAR; PG8_WAIT_L(0); PG8_MMA(0, 1, At, B1); PG8_BAR;
            PG8_LDA(At, 1, 1); PG8_STAGE(PG8_SA(1, 0), a3, voffA);
            PG8_BAR; PG8_WAIT_L(0); PG8_MMA(1, 0, At, B0); PG8_BAR; PG8_SCHED;
            PG8_STAGE(PG8_SB(1, 1), b3 + hstep, voffB);
            PG8_WAIT_V(6); PG8_BAR; PG8_MMA(1, 1, At, B1); PG8_BAR;
            }
        }
        if constexpr (ALIGN_EPI) { if (wr == 0) PG8_BAR; }
        if constexpr (!Epi::AFTER_DRAIN) { E(acc, cur, wr, wc, fr, fq); S.done(cur); }
        if (!has_next) break;
#pragma unroll
        for (int a = 0; a < 2; ++a)
#pragma unroll
            for (int b = 0; b < 2; ++b)
#pragma unroll
                for (int m = 0; m < 4; ++m)
#pragma unroll
                    for (int n = 0; n < 2; ++n) acc[a][b][m][n] = (f32x4){0.f, 0.f, 0.f, 0.f};
        cur = nxt; cA = nA; cB = nB; ++ui;
        if constexpr (ALIGN_EPI) { if (wr == 1) PG8_BAR; }
    }
    PG8_WAIT_V(0);
    if constexpr (!ALIGN_EPI) { if (wr == 0) PG8_BAR; }
    PG8_BAR;
    if constexpr (Epi::AFTER_DRAIN) { E.fused(acc, cur, wr, wc, fr, fq, lds, wid, lane); S.done(cur); }
#undef PG8_SA
#undef PG8_SB
#undef PG8_STAGE
#undef PG8_LDA
#undef PG8_LDB
#undef PG8_MMA
#undef PG8_WAIT_V
#undef PG8_WAIT_L
#undef PG8_BAR
#undef PG8_SCHED
}
}
#define GAS __attribute__((address_space(1)))
#define LAS __attribute__((address_space(3)))
typedef unsigned short bf16;
typedef unsigned v4u __attribute__((ext_vector_type(4)));
typedef unsigned v2u __attribute__((ext_vector_type(2)));
typedef float f32x4 __attribute__((ext_vector_type(4)));
typedef float f32x2 __attribute__((ext_vector_type(2)));
typedef short bf16x8 __attribute__((ext_vector_type(8)));
typedef short s16x4 __attribute__((ext_vector_type(4)));

constexpr int NB = 8, T = 2048, D = 2048, M = NB * T;
constexpr int NIN = 6784, NP = 6912;
constexpr int C_Q = 0, C_K = 1024, C_V = 1280, C_GA = 1536, C_R = 2560, C_RK = 3584, C_RV = 4608, C_WD = 5632, C_AD = 5696, C_GR = 5760;
constexpr size_t MiB = 1u << 20;
constexpr size_t WS_MOD = 0;
constexpr size_t WS_CTL = 512 * 1024, CTL_BYTES = 32768;
constexpr size_t WS_WIN = 2 * MiB;
constexpr size_t WS_WOUT = 29 * MiB;
constexpr size_t WS_H = 40 * MiB;
constexpr size_t WS_PROJ = 104 * MiB;
constexpr size_t WS_MIXOUT = 320 * MiB;
constexpr size_t WS_XW = 2 * MiB;
constexpr size_t WS_XA = 4 * MiB;
constexpr size_t WS_RN = 6 * MiB;
constexpr size_t WS_IMGA = 7 * MiB;
constexpr size_t WS_IMGB = 320 * MiB;
constexpr size_t WS_END = 500 * MiB;
constexpr int LDS_BYTES = 147456, RING_BYTES = 131072;
constexpr int NWAVES = 8;

__device__ __forceinline__ float rcp_f(float v) { return __builtin_amdgcn_rcpf(v); }
#define LDS_WAIT() asm volatile("s_waitcnt lgkmcnt(0)" ::: "memory")
__device__ __forceinline__ unsigned f2bf(float f) { unsigned u = __builtin_bit_cast(unsigned, f); return (u + 0x7fffu + ((u >> 16) & 1u)) >> 16; }
typedef __bf16 bf16x2_t __attribute__((ext_vector_type(2)));
__device__ __forceinline__ unsigned pk2(float lo, float hi) { const f32x2 v = {lo, hi}; return __builtin_bit_cast(unsigned, __builtin_convertvector(v, bf16x2_t)); }
__device__ __forceinline__ float tanh_f(float v) { return 1.f - 2.f * rcp_f(__expf(2.f * v) + 1.f); }
__device__ __forceinline__ float bflo(unsigned u) { return __builtin_bit_cast(float, u << 16); }
__device__ __forceinline__ float bfhi(unsigned u) { return __builtin_bit_cast(float, u & 0xffff0000u); }
__device__ __forceinline__ float silu_f(float v) { return v * rcp_f(1.f + __expf(-v)); }
__device__ __forceinline__ float wave_sum(float v) {
#pragma unroll
    for (int o = 1; o < 64; o <<= 1) v += __shfl_xor(v, o);
    return v;
}
template <int CTRL> __device__ __forceinline__ float dpp_add(float x) {
    const int y = __builtin_amdgcn_update_dpp(0, __builtin_bit_cast(int, x), CTRL, 0xF, 0xF, false);
    return x + __builtin_bit_cast(float, y);
}
__device__ __forceinline__ float reduce16(float x) {
    x = dpp_add<0x128>(x); x = dpp_add<0x124>(x); x = dpp_add<0x122>(x); x = dpp_add<0x121>(x);
    return x;
}
__device__ __forceinline__ float half_sum(float v) {
    v = reduce16(v); v += __shfl_xor(v, 16);
    return v;
}
struct Args { const float* in[19]; float* out; unsigned char* ws; };

__device__ __forceinline__ void p0_transpose_item(const float* W, int K, int N, bf16* WT, LAS float* scr, int item, int lane) {
    const int nblk = N / 32, kb = item / nblk, nb = item % nblk, k0 = 64 * kb, n0 = 32 * nb;
    float wv[32];
#pragma unroll
    for (int i = 0; i < 32; ++i) wv[i] = W[(size_t)(k0 + 2 * i + (lane >> 5)) * N + n0 + (lane & 31)];
#pragma unroll
    for (int i = 0; i < 32; ++i) scr[(2 * i + (lane >> 5)) * 33 + (lane & 31)] = wv[i];
    LDS_WAIT(); asm volatile("" ::: "memory");
    const int c = lane & 7;
#pragma unroll
    for (int j = 0; j < 4; ++j) { const int n = (lane >> 3) + 8 * j; const LAS float* s = scr + (8 * c) * 33 + n;
        v4u o; o.x = pk2(s[0 * 33], s[1 * 33]); o.y = pk2(s[2 * 33], s[3 * 33]); o.z = pk2(s[4 * 33], s[5 * 33]); o.w = pk2(s[6 * 33], s[7 * 33]);
        *(v4u*)(WT + (size_t)(n0 + n) * K + k0 + 8 * c) = o; }
    LDS_WAIT(); asm volatile("" ::: "memory");
}

__device__ __forceinline__ void mod_cols(LAS unsigned char* lds, const Args& a, int j, int tid) {
    const float* c = a.in[1]; const float* w_ada = a.in[2]; const float* b_ada = a.in[3];
    float* mod = (float*)(a.ws + WS_MOD);
    LAS float* s = (LAS float*)lds;
    LAS float* red = s + 16384;
    for (int i = tid; i < 8 * 2048; i += 512) s[i] = silu_f(c[i]);
    __syncthreads();
    const int cgp = tid & 7, kp = tid >> 3;
    float acc[8][4];
#pragma unroll
    for (int b = 0; b < 8; ++b)
#pragma unroll
        for (int e = 0; e < 4; ++e) acc[b][e] = 0.f;
#pragma unroll 8
    for (int i = 0; i < 32; ++i) {
        const int k = kp + 64 * i;
        const f32x4 wv = *(const f32x4*)(w_ada + (size_t)k * 6144 + 32 * j + 4 * cgp);
#pragma unroll
        for (int b = 0; b < 8; ++b) { const float sv = s[b * 2048 + k];
#pragma unroll
            for (int e = 0; e < 4; ++e) acc[b][e] += sv * wv[e]; }
    }
#pragma unroll
    for (int b = 0; b < 8; ++b)
#pragma unroll
        for (int e = 0; e < 4; ++e) red[kp * 256 + b * 32 + 4 * cgp + e] = acc[b][e];
    __syncthreads();
    if (tid < 256) {
        float sum = 0.f;
        for (int q = 0; q < 64; ++q) sum += red[q * 256 + tid];
        const int b = tid >> 5, col = tid & 31;
        mod[b * 6144 + 32 * j + col] = sum + b_ada[32 * j + col];
    }
    __syncthreads();
}
__device__ __forceinline__ void phase0(LAS unsigned char* lds, const Args& a, int tid, int wave, int lane) {
    if (blockIdx.x < 128) mod_cols(lds, a, (int)blockIdx.x, tid);
    LAS float* scr = (LAS float*)(lds + wave * 16384);
    bf16* WinT = (bf16*)(a.ws + WS_WIN);
    constexpr int I_IN = (D / 64) * (NIN / 32), I_LO = 128 * NWAVES, PER_HI = (I_IN - I_LO) / 128;
    static_assert(I_LO + 128 * PER_HI == I_IN, "w_in item split");
    if (blockIdx.x < 128) p0_transpose_item(a.in[6], D, NIN, WinT, scr, (int)blockIdx.x * NWAVES + wave, lane);
    else for (int q = wave; q < PER_HI; q += NWAVES) p0_transpose_item(a.in[6], D, NIN, WinT, scr, I_LO + ((int)blockIdx.x - 128) * PER_HI + q, lane);
    { v4u* z = (v4u*)(WinT + (size_t)NIN * D); const int nz = (NP - NIN) * D * 2 / 16;
      for (int i = blockIdx.x * 512 + tid; i < nz; i += gridDim.x * 512) z[i] = (v4u){0u, 0u, 0u, 0u}; }
}

__device__ __forceinline__ void phase1(const Args& a, int wave, int lane) {
    const float* x = a.in[0]; const float* g = a.in[4];
    const float* mod = (const float*)(a.ws + WS_MOD); bf16* H = (bf16*)(a.ws + WS_H);
    const int gw = blockIdx.x * NWAVES + wave, NGW = gridDim.x * NWAVES;
    for (int m = gw; m < M; m += NGW) {
        const int b = m >> 11;
        const f32x4* xr = (const f32x4*)(x + (size_t)m * D) + lane;
        f32x4 v[8]; float ss = 0.f;
#pragma unroll
        for (int j = 0; j < 8; ++j) { v[j] = xr[64 * j]; ss += (v[j].x * v[j].x + v[j].y * v[j].y) + (v[j].z * v[j].z + v[j].w * v[j].w); }
        const float rinv = rsqrtf(wave_sum(ss) * (1.f / D) + 1e-6f);
        v2u* o8 = (v2u*)(H + (size_t)m * D) + lane;
#pragma unroll
        for (int j = 0; j < 8; ++j) {
            const int col = 4 * lane + 256 * j;
            const f32x4 g4 = *(const f32x4*)(g + col);
            const f32x4 sh = *(const f32x4*)(mod + b * 6144 + col);
            const f32x4 sc = *(const f32x4*)(mod + b * 6144 + 2048 + col);
            const f32x4 o = v[j] * rinv * g4 * (sc + 1.f) + sh;
            v2u w; w.x = pk2(o.x, o.y); w.y = pk2(o.z, o.w);
            o8[64 * j] = w;
        }
    }
}

__device__ __forceinline__ void attn_phase(LAS unsigned char* lds, const bf16* P, bf16* mix, const float* sinks, int u0, int ustride, int nunits, int tid, int wave, int lane) {
    constexpr int KP = 72, VP = 264;
    LAS bf16* Ks = (LAS bf16*)lds;
    LAS bf16* Vt = (LAS bf16*)(lds + 36864);
    const int c = lane & 15, hq = lane >> 4, g = wave >> 1, half = wave & 1;
    v4u kv[4], vv[4];
#define A_LOAD(uu) do { const int b_ = (uu) >> 6, n_ = ((uu) >> 2) & 15, hk_ = (uu) & 3; \
        _Pragma("unroll") for (int i = 0; i < 4; ++i) { const int idx = tid + 512 * i, key = idx >> 3, part = idx & 7, tok = (n_ - 1) * 128 + key; \
            kv[i] = (v4u){0u, 0u, 0u, 0u}; vv[i] = (v4u){0u, 0u, 0u, 0u}; \
            if (tok >= 0) { const size_t row = (size_t)(b_ * T + tok) * NP; kv[i] = *(const v4u*)(P + row + C_K + hk_ * 64 + part * 8); vv[i] = *(const v4u*)(P + row + C_V + hk_ * 64 + part * 8); } } } while (0)
    A_LOAD(u0);
    for (int ui = 0; ui < nunits; ++ui) {
        const int u = u0 + ui * ustride, b = u >> 6, n = (u >> 2) & 15, hk = u & 3, head = hk * 4 + g;
#pragma unroll
        for (int i = 0; i < 4; ++i) { const int idx = tid + 512 * i, key = idx >> 3, part = idx & 7;
            *(LAS v4u*)(Ks + key * KP + part * 8) = kv[i];
#pragma unroll
            for (int e = 0; e < 8; ++e) Vt[(part * 8 + e) * VP + key] = (bf16)((vv[i][e >> 1] >> (16 * (e & 1))) & 0xffffu); }
        __syncthreads();
        if (ui + 1 < nunits) A_LOAD(u + ustride);
        const float sink = sinks[head];
        const size_t rowq = (size_t)(b * T + n * 128 + half * 64 + c);
        bf16x8 qf[2], nqf[2]; v2u ga[4], nga[4];
#pragma unroll
        for (int ks = 0; ks < 2; ++ks) qf[ks] = *(const bf16x8*)(P + rowq * NP + C_Q + head * 64 + 32 * ks + 8 * hq);
#pragma unroll
        for (int dt = 0; dt < 4; ++dt) ga[dt] = *(const v2u*)(P + rowq * NP + C_GA + head * 64 + 16 * dt + 4 * hq);
        for (int ch = 0; ch < 4; ++ch) {
            const int q0 = half * 64 + ch * 16, tb = ((q0 >> 4) >> 1) * 2;
            if (ch + 1 < 4) { const size_t rn = (rowq + 16 * (ch + 1)) * NP;
#pragma unroll
                for (int ks = 0; ks < 2; ++ks) nqf[ks] = *(const bf16x8*)(P + rn + C_Q + head * 64 + 32 * ks + 8 * hq);
#pragma unroll
                for (int dt = 0; dt < 4; ++dt) nga[dt] = *(const v2u*)(P + rn + C_GA + head * 64 + 16 * dt + 4 * hq); }
            f32x4 s[10];
#pragma unroll
            for (int tl = 0; tl < 10; ++tl) {
                f32x4 acc = (f32x4){0.f, 0.f, 0.f, 0.f};
#pragma unroll
                for (int ks = 0; ks < 2; ++ks) { const bf16x8 kf = *(const LAS bf16x8*)(Ks + (16 * (tb + tl) + c) * KP + 32 * ks + 8 * hq);
                    acc = __builtin_amdgcn_mfma_f32_16x16x32_bf16(kf, qf[ks], acc, 0, 0, 0); }
                s[tl] = acc;
            }
            const int qi = q0 + c;
            float mx = sink;
#pragma unroll
            for (int tl = 0; tl < 10; ++tl)
#pragma unroll
                for (int r = 0; r < 4; ++r) { const int si = 16 * (tb + tl) + 4 * hq + r;
                    const bool valid = (si > qi) && (si <= qi + 128) && (n > 0 || si >= 128);
                    const float sv = valid ? s[tl][r] * 0.125f : -1e30f; s[tl][r] = sv; mx = fmaxf(mx, sv); }
            mx = fmaxf(mx, __shfl_xor(mx, 16)); mx = fmaxf(mx, __shfl_xor(mx, 32));
            float sum = 0.f;
#pragma unroll
            for (int tl = 0; tl < 10; ++tl)
#pragma unroll
                for (int r = 0; r < 4; ++r) { const float p = __expf(s[tl][r] - mx); s[tl][r] = p; sum += p; }
            sum += __shfl_xor(sum, 16); sum += __shfl_xor(sum, 32);
            const float inv = rcp_f(sum + __expf(sink - mx));
            f32x4 o[4];
#pragma unroll
            for (int dt = 0; dt < 4; ++dt) o[dt] = (f32x4){0.f, 0.f, 0.f, 0.f};
#pragma unroll
            for (int kp = 0; kp < 5; ++kp) {
                v4u pw; pw.x = pk2(s[2 * kp][0], s[2 * kp][1]); pw.y = pk2(s[2 * kp][2], s[2 * kp][3]); pw.z = pk2(s[2 * kp + 1][0], s[2 * kp + 1][1]); pw.w = pk2(s[2 * kp + 1][2], s[2 * kp + 1][3]);
                const bf16x8 pf = __builtin_bit_cast(bf16x8, pw);
#pragma unroll
                for (int dt = 0; dt < 4; ++dt) {
                    const v2u v0 = *(const LAS v2u*)(Vt + (16 * dt + c) * VP + 16 * (tb + 2 * kp) + 4 * hq);
                    const v2u v1 = *(const LAS v2u*)(Vt + (16 * dt + c) * VP + 16 * (tb + 2 * kp + 1) + 4 * hq);
                    v4u vw; vw.x = v0.x; vw.y = v0.y; vw.z = v1.x; vw.w = v1.y;
                    o[dt] = __builtin_amdgcn_mfma_f32_16x16x32_bf16(__builtin_bit_cast(bf16x8, vw), pf, o[dt], 0, 0, 0);
                }
            }
            bf16* orow = mix + (rowq + 16 * ch) * D + head * 64 + 4 * hq;
#pragma unroll
            for (int dt = 0; dt < 4; ++dt) {
                const float g0 = bflo(ga[dt].x), g1 = bfhi(ga[dt].x), g2 = bflo(ga[dt].y), g3 = bfhi(ga[dt].y);
                v2u w; w.x = pk2(o[dt][0] * inv * silu_f(g0), o[dt][1] * inv * silu_f(g1)); w.y = pk2(o[dt][2] * inv * silu_f(g2), o[dt][3] * inv * silu_f(g3));
                *(v2u*)(orow + 16 * dt) = w;
            }
#pragma unroll
            for (int ks = 0; ks < 2; ++ks) qf[ks] = nqf[ks];
#pragma unroll
            for (int dt = 0; dt < 4; ++dt) ga[dt] = nga[dt];
        }
        __syncthreads();
    }
#undef A_LOAD
}

#define XB_TMO      128
#define XB_XCNT(j)  (256  + 64 * (j))
#define XB_XSUB(j)  (1280 + 64 * (j))
#define XB_XGEN(j)  (2304 + 64 * (j))
#define XB_TOP      3328
#define XB_TOPGEN   3392
#define XCD_BAR_WORDS 3456
#define XB_SPIN_CAP (1u << 18)

__device__ __forceinline__ unsigned xb_ld(unsigned* p)              { return __hip_atomic_load(p, __ATOMIC_RELAXED, __HIP_MEMORY_SCOPE_AGENT); }
__device__ __forceinline__ unsigned xb_add(unsigned* p, unsigned v) { return __hip_atomic_fetch_add(p, v, __ATOMIC_RELAXED, __HIP_MEMORY_SCOPE_AGENT); }
__device__ __forceinline__ unsigned xb_xcc_id() { return (unsigned)__builtin_amdgcn_s_getreg((3 << 11) | 20) & 0xFu; }
#define XB_SPIN(cond, bar) do { unsigned _sp = 0; while (cond) { __builtin_amdgcn_s_sleep(1); \
    if ((++_sp & 255u) == 0u) { if (xb_ld(&(bar)[XB_TMO])) break; if (_sp > XB_SPIN_CAP) { atomicAdd(&(bar)[XB_TMO], 1u); break; } } } } while (0)

struct XcdBarrier {
    unsigned* bar; unsigned x;
    volatile LAS unsigned* st;
};

__device__ __forceinline__ XcdBarrier xcd_barrier_post(unsigned* bar, volatile LAS unsigned* st) {
    XcdBarrier b; b.bar = bar; b.x = xb_xcc_id(); b.st = st;
    if (threadIdx.x == 0) (void)xb_add(&bar[XB_XCNT(b.x)], 1u);
    return b;
}
__device__ __forceinline__ void xcd_barrier_complete(unsigned* bar, unsigned x, unsigned& nloc, unsigned& nx) {
    const unsigned G = gridDim.x * gridDim.y * gridDim.z;
    unsigned sum, cnt, mine, sp = 0u;
    for (;;) {
        sum = 0u; cnt = 0u; mine = 0u;
#pragma unroll
        for (unsigned j = 0; j < 16; ++j) { const unsigned c = xb_ld(&bar[XB_XCNT(j)]); sum += c; cnt += (c > 0u) ? 1u : 0u; mine = (j == x) ? c : mine; }
        if (sum == G) break;
        __builtin_amdgcn_s_sleep(1);
        if ((++sp & 255u) == 0u) { if (xb_ld(&bar[XB_TMO])) break; if (sp > XB_SPIN_CAP) { atomicAdd(&bar[XB_TMO], 1u); break; } }
    }
    nloc = mine > 0u ? mine : 1u; nx = cnt > 0u ? cnt : 1u;
}

__device__ __forceinline__ void xcd_barrier(const XcdBarrier& b) {
    asm volatile("s_waitcnt vmcnt(0)" ::: "memory");
    __syncthreads();
    if (threadIdx.x == 0) {
        unsigned* bar = b.bar;
        __builtin_amdgcn_s_waitcnt(0);
        unsigned nloc = b.st[0], nx = b.st[1];
        if (nloc == 0u) { xcd_barrier_complete(bar, b.x, nloc, nx); b.st[0] = nloc; b.st[1] = nx; }
        const unsigned old = xb_add(&bar[XB_XSUB(b.x)], 1u);
        const unsigned gen = old / nloc;
        if (old + 1u == (gen + 1u) * nloc) {
            __builtin_amdgcn_fence(__ATOMIC_RELEASE, "agent");
            asm volatile("s_waitcnt vmcnt(0)" ::: "memory");
            const unsigned og = xb_add(&bar[XB_TOP], 1u);
            const unsigned tg = og / nx;
            if (og + 1u == (tg + 1u) * nx) xb_add(&bar[XB_TOPGEN], 1u);
            else XB_SPIN(xb_ld(&bar[XB_TOPGEN]) == tg, bar);
            __builtin_amdgcn_fence(__ATOMIC_ACQUIRE, "agent");
            xb_add(&bar[XB_XGEN(b.x)], 1u);
            asm volatile("s_waitcnt vmcnt(0)" ::: "memory");
        } else {
            XB_SPIN(xb_ld(&bar[XB_XGEN(b.x)]) == gen, bar);
            __builtin_amdgcn_fence(__ATOMIC_ACQUIRE, "agent");
            asm volatile("s_waitcnt vmcnt(0)" ::: "memory");
        }
    }
    __syncthreads();
}
__device__ __forceinline__ void phase25(const Args& a, int wave, int lane) {
    const bf16* P = (const bf16*)(a.ws + WS_PROJ);
    bf16* XW = (bf16*)(a.ws + WS_XW); bf16* XA = (bf16*)(a.ws + WS_XA); float* RN = (float*)(a.ws + WS_RN);
    const float* mu = a.in[9]; const float* k_k = a.in[14];
    const float mu_w = mu[3072 + lane], mu_a = mu[3136 + lane];
    float muk[16], kkc[16];
#pragma unroll
    for (int j = 0; j < 16; ++j) { muk[j] = mu[1024 + lane * 16 + j]; kkc[j] = k_k[lane * 16 + j]; }
    const int gw = blockIdx.x * NWAVES + wave, NGW = gridDim.x * NWAVES;
    for (int m = gw; m < M; m += NGW) {
        const bool first = (m & (T - 1)) == 0;
        const bf16* pr = P + (size_t)m * NP;
        const float wc = bflo((unsigned)pr[C_WD + lane]), ac = bflo((unsigned)pr[C_AD + lane]);
        const float wp = first ? 0.f : bflo((unsigned)pr[C_WD + lane - NP]), ap = first ? 0.f : bflo((unsigned)pr[C_AD + lane - NP]);
        XW[(size_t)m * 64 + lane] = (bf16)f2bf(tanh_f(wc + (wp - wc) * mu_w));
        XA[(size_t)m * 64 + lane] = (bf16)f2bf(ac + (ap - ac) * mu_a);
        v4u kc[2], kp[2];
#pragma unroll
        for (int h = 0; h < 2; ++h) { kc[h] = *(const v4u*)(pr + C_RK + lane * 16 + 8 * h);
            kp[h] = first ? (v4u){0u, 0u, 0u, 0u} : *(const v4u*)(pr - NP + C_RK + lane * 16 + 8 * h); }
        float ssq = 0.f;
#pragma unroll
        for (int h = 0; h < 2; ++h)
#pragma unroll
            for (int j = 0; j < 4; ++j) {
                const float c0 = bflo(kc[h][j]), c1 = bfhi(kc[h][j]), p0 = bflo(kp[h][j]), p1 = bfhi(kp[h][j]);
                const float k0 = (c0 + (p0 - c0) * muk[8 * h + 2 * j]) * kkc[8 * h + 2 * j], k1 = (c1 + (p1 - c1) * muk[8 * h + 2 * j + 1]) * kkc[8 * h + 2 * j + 1];
                ssq += k0 * k0 + k1 * k1; }
        ssq = dpp_add<0xB1>(ssq); ssq = dpp_add<0x4E>(ssq);
        if ((lane & 3) == 0) RN[(size_t)m * 16 + (lane >> 2)] = rsqrtf(fmaxf(ssq, 1e-24f));
    }
}

constexpr int TC = 16, NCH = T / TC;
constexpr int IMG = 12864, I_PA = 0, I_A2 = 4096, I_V = 8192, I_DE = 12288, I_SC = 12544, I_BON = 12800;
constexpr int STG = 14144, P_SC = 12864, P_BON = 13888;
#define WG_BAR() do { asm volatile("s_waitcnt lgkmcnt(0)" ::: "memory"); __builtin_amdgcn_s_barrier(); asm volatile("" ::: "memory"); } while (0)
__device__ __forceinline__ unsigned char* img_ptr(unsigned char* ws, int chain, int chunk) {
    return chain < 14 ? ws + WS_IMGA + ((size_t)chain * NCH + chunk) * IMG : ws + WS_IMGB + ((size_t)(chain - 14) * NCH + chunk) * IMG;
}

__device__ __forceinline__ void rwkv_prepass(LAS unsigned char* lds, const Args& a, int tid, int wave, int lane, int cb, int nch, int G, int bidx) {
    const bf16* P = (const bf16*)(a.ws + WS_PROJ);
    const bf16* XW = (const bf16*)(a.ws + WS_XW); const bf16* XA = (const bf16*)(a.ws + WS_XA); const float* RN = (const float*)(a.ws + WS_RN);
    const int g = wave >> 2, hw = wave & 3, grp = bidx * 2 + g, gpc = G >> 6, ntask = nch / gpc, chain = grp / gpc, c0 = cb + (grp % gpc) * ntask;
    const int b = chain >> 4; const unsigned hh = chain & 15, rowbase = (unsigned)b * T;
    const unsigned cc = lane & 15, hq = lane >> 4; const int ch = 16 * hw + (int)cc; const unsigned col = hh * 64 + ch; const int tg = tid & 255;
    const float* mu = a.in[9];
    const float cw0 = a.in[10][col], ca0 = a.in[12][col], ckk = a.in[14][col], cka = a.in[15][col], crk = a.in[16][col];
    const float mur = mu[col], muk = mu[1024 + col], muv = mu[2048 + col];
    bf16x8 bwf[2], baf[2];
#pragma unroll
    for (int ks = 0; ks < 2; ++ks) {
        float tw[8], ta[8];
#pragma unroll
        for (int j = 0; j < 8; ++j) { const size_t o = (size_t)(32 * ks + 8 * hq + j) * 1024 + col; tw[j] = a.in[11][o]; ta[j] = a.in[13][o]; }
        v4u w; w.x = pk2(tw[0], tw[1]); w.y = pk2(tw[2], tw[3]); w.z = pk2(tw[4], tw[5]); w.w = pk2(tw[6], tw[7]); bwf[ks] = __builtin_bit_cast(bf16x8, w);
        v4u v; v.x = pk2(ta[0], ta[1]); v.y = pk2(ta[2], ta[3]); v.z = pk2(ta[4], ta[5]); v.w = pk2(ta[6], ta[7]); baf[ks] = __builtin_bit_cast(bf16x8, v);
    }
    const int pa_w = (hw >> 1) * 256 + (cc >> 2) * 16 + ((hw & 1) * 4 + (cc & 3)) * 2;
    v4u n_aw[2], n_aa[2], c_aw[2], c_aa[2], m_aw[2], m_aa[2];
    unsigned n_rc[4], n_kc[4], n_vc[4], n_rp, n_kp, n_vp, c_rc[4], c_kc[4], c_vc[4], c_rp, c_kp, c_vp, m_rc[4], m_kc[4], m_vc[4], m_rp, m_kp, m_vp;
    float n_rn[4], c_rn[4], m_rn[4];
#define H_LOAD(k) do { const unsigned t0_ = (unsigned)(k) * TC; const unsigned ra_ = (rowbase + t0_ + cc) * 64u + 8u * hq; \
        _Pragma("unroll") for (int ks = 0; ks < 2; ++ks) { n_aw[ks] = *(const v4u*)(XW + (ra_ + 32u * ks)); n_aa[ks] = *(const v4u*)(XA + (ra_ + 32u * ks)); } \
        const unsigned tb_ = t0_ + 4u * hq, pe_ = (rowbase + tb_) * (unsigned)NP + col; \
        _Pragma("unroll") for (int r = 0; r < 4; ++r) { n_rc[r] = P[pe_ + (unsigned)(r * NP + C_R)]; n_kc[r] = P[pe_ + (unsigned)(r * NP + C_RK)]; n_vc[r] = P[pe_ + (unsigned)(r * NP + C_RV)]; \
            n_rn[r] = RN[(rowbase + tb_ + r) * 16u + hh]; } \
        if (tb_ > 0u) { n_rp = P[pe_ - (unsigned)(NP - C_R)]; n_kp = P[pe_ - (unsigned)(NP - C_RK)]; n_vp = P[pe_ - (unsigned)(NP - C_RV)]; } else { n_rp = 0u; n_kp = 0u; n_vp = 0u; } \
    } while (0)
#define H_ADV() do { _Pragma("unroll") for (int ks = 0; ks < 2; ++ks) { c_aw[ks] = m_aw[ks]; c_aa[ks] = m_aa[ks]; m_aw[ks] = n_aw[ks]; m_aa[ks] = n_aa[ks]; } \
        _Pragma("unroll") for (int r = 0; r < 4; ++r) { c_rc[r] = m_rc[r]; c_kc[r] = m_kc[r]; c_vc[r] = m_vc[r]; c_rn[r] = m_rn[r]; m_rc[r] = n_rc[r]; m_kc[r] = n_kc[r]; m_vc[r] = n_vc[r]; m_rn[r] = n_rn[r]; } \
        c_rp = m_rp; c_kp = m_kp; c_vp = m_vp; m_rp = n_rp; m_kp = n_kp; m_vp = n_vp; } while (0)
    H_LOAD(c0); H_ADV(); H_LOAD(c0 + 1);
    for (int k = 0; k < ntask; ++k) {
        LAS unsigned char* B_ = lds + (g * 2 + (k & 1)) * STG;
        H_ADV();
        if (k + 2 < ntask) H_LOAD(c0 + k + 2);
        f32x4 accw = (f32x4){0.f, 0.f, 0.f, 0.f}, acca = (f32x4){0.f, 0.f, 0.f, 0.f};
#pragma unroll
        for (int ks = 0; ks < 2; ++ks) { accw = __builtin_amdgcn_mfma_f32_16x16x32_bf16(__builtin_bit_cast(bf16x8, c_aw[ks]), bwf[ks], accw, 0, 0, 0);
            acca = __builtin_amdgcn_mfma_f32_16x16x32_bf16(__builtin_bit_cast(bf16x8, c_aa[ks]), baf[ks], acca, 0, 0, 0); }
        float dec_[4], rr_[4], vx_[4], kkn_[4], k2_[4], bv_[4], pbo_[4], psc_[2][8];
#pragma unroll
        for (int r = 0; r < 4; ++r) {
            const float rcu = bflo(c_rc[r]), kcu = bflo(c_kc[r]), vcu = bflo(c_vc[r]);
            const float rpv = bflo(r == 0 ? c_rp : c_rc[r > 0 ? r - 1 : 0]), kpv = bflo(r == 0 ? c_kp : c_kc[r > 0 ? r - 1 : 0]), vpv = bflo(r == 0 ? c_vp : c_vc[r > 0 ? r - 1 : 0]);
            const float rr = rcu + (rpv - rcu) * mur, kx = kcu + (kpv - kcu) * muk; vx_[r] = vcu + (vpv - vcu) * muv;
            dec_[r] = __expf(-0.60653066f * rcp_f(1.f + __expf(-(cw0 + accw[r]))));
            const float ic = rcp_f(1.f + __expf(-(ca0 + acca[r])));
            const float kkn = kx * ckk * c_rn[r], k2 = kx * (1.f + (ic - 1.f) * cka), bv = kkn * ic;
            rr_[r] = rr; kkn_[r] = kkn; k2_[r] = k2; bv_[r] = bv;
            pbo_[r] = reduce16(rr * k2 * crk); }
#pragma unroll
        for (int pl = 0; pl < 2; ++pl) { const int r0 = 2 * pl, r1 = r0 + 1; const float wr1 = dec_[r1] * rr_[r1];
            psc_[pl][0] = reduce16(bv_[r0] * rr_[r0]); psc_[pl][1] = reduce16(k2_[r0] * rr_[r0]);
            psc_[pl][2] = reduce16(-bv_[r0] * kkn_[r1]); psc_[pl][3] = reduce16(-k2_[r0] * kkn_[r1]);
            psc_[pl][4] = reduce16(bv_[r0] * wr1); psc_[pl][5] = reduce16(k2_[r0] * wr1);
            psc_[pl][6] = reduce16(bv_[r1] * rr_[r1]); psc_[pl][7] = reduce16(k2_[r1] * rr_[r1]); }
        if (cc == 0) {
#pragma unroll
            for (int r = 0; r < 4; ++r) *(LAS float*)(B_ + P_BON + ((4 * hq + r) * 4 + hw) * 4) = pbo_[r];
#pragma unroll
            for (int pl = 0; pl < 2; ++pl)
#pragma unroll
                for (int e = 0; e < 8; ++e) *(LAS float*)(B_ + P_SC + (((2 * hq + pl) * 8 + e) * 4 + hw) * 4) = psc_[pl][e]; }
        { float D_[4], Dp_[4]; const float p0 = dec_[0], p1 = p0 * dec_[1], p2 = p1 * dec_[2], p3 = p2 * dec_[3];
          const float g0 = __shfl(p3, cc), g1 = __shfl(p3, cc + 16), g2 = __shfl(p3, cc + 32);
          const float E_ = hq == 0 ? 1.f : (hq == 1 ? g0 : (hq == 2 ? g0 * g1 : g0 * g1 * g2));
          D_[0] = E_ * p0; D_[1] = E_ * p1; D_[2] = E_ * p2; D_[3] = E_ * p3; Dp_[0] = E_; Dp_[1] = D_[0]; Dp_[2] = D_[1]; Dp_[3] = D_[2];
#pragma unroll
          for (int r = 0; r < 4; ++r) { const int pr_ = 2 * hq + (r >> 1), od = r & 1; const float rcp = rcp_f(D_[r]);
            const unsigned pw_ = pk2(-kkn_[r] * Dp_[r], D_[r] * rr_[r]);
            *(LAS bf16*)(B_ + I_PA + pr_ * 512 + od * 128 + pa_w) = (bf16)(pw_ & 0xffffu); *(LAS bf16*)(B_ + I_PA + pr_ * 512 + od * 128 + 64 + pa_w) = (bf16)(pw_ >> 16);
            *(LAS unsigned*)(B_ + I_A2 + (pr_ * 64 + ch) * 8 + od * 4) = pk2(bv_[r] * rcp, k2_[r] * rcp); *(LAS float*)(B_ + I_V + (pr_ * 64 + ch) * 8 + od * 4) = vx_[r]; }
          if (hq == 3) *(LAS float*)(B_ + I_DE + ch * 4) = D_[3]; }
        WG_BAR();
        unsigned char* gi = img_ptr(a.ws, chain, c0 + k);
#pragma unroll
        for (int i = 0; i < 3; ++i) *(v4u*)(gi + (tg + 256 * i) * 16) = *(const LAS v4u*)(B_ + (tg + 256 * i) * 16);
        if (tg < 16) *(v4u*)(gi + I_DE + tg * 16) = *(const LAS v4u*)(B_ + I_DE + tg * 16);
        else if (tg < 36) { const int j_ = tg - 16;
            const LAS unsigned char* pp_ = B_ + (j_ < 16 ? P_SC + j_ * 64 : P_BON + (j_ - 16) * 64);
            f32x4 o_;
#pragma unroll
            for (int e = 0; e < 4; ++e) { const f32x4 q_ = *(const LAS f32x4*)(pp_ + e * 16); o_[e] = (q_[0] + q_[1]) + (q_[2] + q_[3]); }
            *(f32x4*)(gi + (j_ < 16 ? I_SC + j_ * 16 : I_BON + (j_ - 16) * 16)) = o_; }
    }
    WG_BAR();
#undef H_LOAD
#undef H_ADV
}

constexpr int O_Y = 3 * IMG;
__device__ __forceinline__ void rwkv_block(LAS unsigned char* lds, const Args& a, int chain, int cbeg, int cend, f32x4 (&st)[4], int tid, int wave, int lane) {
    const int b = chain >> 4, hh = chain & 15, rowbase = b * T;
    if (wave < 4) {
        const int i = lane & 15, hq = lane >> 4, n = 16 * wave + i;
        const unsigned hmask = hq == 0 ? 0xffffffffu : 0u;
        const int pa_off = (i & 3) * 64 + hq * 16;
        const f32x4 zero4 = (f32x4){0.f, 0.f, 0.f, 0.f};
        WG_BAR();
        __builtin_amdgcn_s_setprio(3);
        int bi = 0;
        for (int c = cbeg; c < cend; ++c) {
            LAS unsigned char* B = lds + bi * IMG;
            LAS unsigned char* Yb = lds + O_Y + (c & 1) * 4096;
            const float scv = *(const LAS float*)(B + I_SC + lane * 4);
            bf16x8 pa0 = *(const LAS bf16x8*)(B + I_PA + pa_off), pa1 = *(const LAS bf16x8*)(B + I_PA + 256 + pa_off);
            f32x2 v2 = *(const LAS f32x2*)(B + I_V + n * 8);
            v2u a2[4];
#pragma unroll
            for (int q = 0; q < 4; ++q) a2[q] = *(const LAS v2u*)(B + I_A2 + (16 * q + i) * 8);
#pragma unroll
            for (int pp = 0; pp < TC / 2; ++pp) {
                bf16x8 npa0 = pa0, npa1 = pa1; f32x2 nv2 = v2; v2u na2[4];
#pragma unroll
                for (int q = 0; q < 4; ++q) na2[q] = a2[q];
                if (pp + 1 < TC / 2) {
                    npa0 = *(const LAS bf16x8*)(B + I_PA + ((pp + 1) * 2 + 0) * 256 + pa_off); npa1 = *(const LAS bf16x8*)(B + I_PA + ((pp + 1) * 2 + 1) * 256 + pa_off);
                    nv2 = *(const LAS f32x2*)(B + I_V + ((pp + 1) * 64 + n) * 8);
#pragma unroll
                    for (int q = 0; q < 4; ++q) na2[q] = *(const LAS v2u*)(B + I_A2 + ((pp + 1) * 64 + 16 * q + i) * 8);
                }
                __builtin_amdgcn_sched_barrier(0);
                v4u s0, s1;
                s0.x = pk2(st[0][0], st[0][1]); s0.y = pk2(st[0][2], st[0][3]); s0.z = pk2(st[1][0], st[1][1]); s0.w = pk2(st[1][2], st[1][3]);
                s1.x = pk2(st[2][0], st[2][1]); s1.y = pk2(st[2][2], st[2][3]); s1.z = pk2(st[3][0], st[3][1]); s1.w = pk2(st[3][2], st[3][3]);
                const f32x4 d0 = __builtin_amdgcn_mfma_f32_16x16x32_bf16(pa0, __builtin_bit_cast(bf16x8, s0), zero4, 0, 0, 0);
                const f32x4 d1 = __builtin_amdgcn_mfma_f32_16x16x32_bf16(pa1, __builtin_bit_cast(bf16x8, s1), zero4, 0, 0, 0);
                const f32x4 d = d0 + d1;
                float sc[8];
#pragma unroll
                for (int e = 0; e < 8; ++e) sc[e] = __builtin_bit_cast(float, __builtin_amdgcn_readlane(__builtin_bit_cast(int, scv), pp * 8 + e));
                const float sa0 = d[0];
                const float sa1 = d[2] + sa0 * sc[2] + v2[0] * sc[3];
                *(LAS float*)(Yb + ((2 * pp) * 64 + n) * 4) = d[1] + sa0 * sc[0] + v2[0] * sc[1];
                *(LAS float*)(Yb + ((2 * pp + 1) * 64 + n) * 4) = (d[3] + sa0 * sc[4] + v2[0] * sc[5]) + (sa1 * sc[6] + v2[1] * sc[7]);
                v2u bw; bw.x = pk2(sa0, v2[0]) & hmask; bw.y = pk2(sa1, v2[1]) & hmask;
                const s16x4 bfr = __builtin_bit_cast(s16x4, bw);
#pragma unroll
                for (int q = 0; q < 4; ++q) st[q] = __builtin_amdgcn_mfma_f32_16x16x16bf16_1k(__builtin_bit_cast(s16x4, a2[q]), bfr, st[q], 0, 0, 0);
                pa0 = npa0; pa1 = npa1; v2 = nv2;
#pragma unroll
                for (int q = 0; q < 4; ++q) a2[q] = na2[q];
            }
#pragma unroll
            for (int q = 0; q < 4; ++q) st[q] = st[q] * *(const LAS f32x4*)(B + I_DE + (16 * q + 4 * hq) * 4);
            bi = bi == 2 ? 0 : bi + 1;
            WG_BAR();
        }
        __builtin_amdgcn_s_setprio(0);
    } else {
        const bf16* P = (const bf16*)(a.ws + WS_PROJ); bf16* mix = (bf16*)(a.ws + WS_H);
        const int hw = wave - 4, cc = lane & 15, hq = lane >> 4, ch = 16 * hw + cc, col = hh * 64 + ch, tg = tid - 256;
        const float clw = a.in[17][col], clb = a.in[18][col];
        const unsigned char* ibase = img_ptr(a.ws, chain, 0);
        const bf16x8 ones8 = __builtin_bit_cast(bf16x8, (v4u){0x3f803f80u, 0x3f803f80u, 0x3f803f80u, 0x3f803f80u});
        v4u imA[3], itA = (v4u){0u, 0u, 0u, 0u}, imB[3], itB = (v4u){0u, 0u, 0u, 0u}; unsigned gE[4] = {0u, 0u, 0u, 0u}, gO[4] = {0u, 0u, 0u, 0u};
#define I_LOAD(im, it, k) do { const unsigned go_ = (unsigned)((k) * IMG); \
        _Pragma("unroll") for (int i_ = 0; i_ < 3; ++i_) im[i_] = *(const v4u*)(ibase + (go_ + (unsigned)((tg + 256 * i_) * 16))); \
        if (tg < 36) it = *(const v4u*)(ibase + (go_ + (unsigned)(I_DE + tg * 16))); } while (0)
#define I_STORE(im, it, bix) do { LAS unsigned char* B_ = lds + (bix) * IMG; \
        _Pragma("unroll") for (int i_ = 0; i_ < 3; ++i_) *(LAS v4u*)(B_ + (tg + 256 * i_) * 16) = im[i_]; \
        if (tg < 36) *(LAS v4u*)(B_ + I_DE + tg * 16) = it; } while (0)
#define H_GLOAD(gx, k) do { const unsigned pg_ = (unsigned)((rowbase + (k) * TC + 4 * hq) * NP + C_GR + col); \
        _Pragma("unroll") for (int r = 0; r < 4; ++r) gx[r] = P[pg_ + (unsigned)(r * NP)]; } while (0)
#define H_POST(gx, k, bix) do { LAS unsigned char* B_ = lds + (bix) * IMG; LAS unsigned char* Y_ = lds + O_Y + ((k) & 1) * 4096; \
          \
        f32x4 s1_ = (f32x4){0.f, 0.f, 0.f, 0.f}, s2_ = (f32x4){0.f, 0.f, 0.f, 0.f}; \
        _Pragma("unroll") for (int kb = 0; kb < 2; ++kb) { \
            const f32x4 ya = *(const LAS f32x4*)(Y_ + (cc * 64 + 32 * kb + 8 * hq) * 4), yb = *(const LAS f32x4*)(Y_ + (cc * 64 + 32 * kb + 8 * hq + 4) * 4); \
            v4u f1, f2; f1.x = pk2(ya[0], ya[1]); f1.y = pk2(ya[2], ya[3]); f1.z = pk2(yb[0], yb[1]); f1.w = pk2(yb[2], yb[3]); \
            f2.x = pk2(ya[0] * ya[0], ya[1] * ya[1]); f2.y = pk2(ya[2] * ya[2], ya[3] * ya[3]); f2.z = pk2(yb[0] * yb[0], yb[1] * yb[1]); f2.w = pk2(yb[2] * yb[2], yb[3] * yb[3]); \
            s1_ = __builtin_amdgcn_mfma_f32_16x16x32_bf16(__builtin_bit_cast(bf16x8, f1), ones8, s1_, 0, 0, 0); \
            s2_ = __builtin_amdgcn_mfma_f32_16x16x32_bf16(__builtin_bit_cast(bf16x8, f2), ones8, s2_, 0, 0, 0); } \
        _Pragma("unroll") for (int r = 0; r < 4; ++r) { const int t_ = 4 * hq + r; \
            const float yo = *(const LAS float*)(Y_ + (t_ * 64 + ch) * 4), vv = *(const LAS float*)(B_ + I_V + ((t_ >> 1) * 64 + ch) * 8 + (t_ & 1) * 4), bon = *(const LAS float*)(B_ + I_BON + t_ * 4); \
            const float mean = s1_[r] * (1.f / 64.f), var = fmaxf(s2_[r] * (1.f / 64.f) - mean * mean, 0.f), rs = rsqrtf(var + 64e-5f); \
            const float o_ = ((yo - mean) * rs * clw + clb + bon * vv) * silu_f(bflo(gx[r])); \
            mix[(unsigned)((rowbase + (k) * TC + t_) * D + 1024 + col)] = (bf16)(pk2(o_, o_) & 0xffffu); } \
    } while (0)
        I_LOAD(imA, itA, cbeg); I_STORE(imA, itA, 0);
        I_LOAD(imA, itA, cbeg + 1); I_LOAD(imB, itB, cbeg + 2);
        H_GLOAD(gE, cbeg);
        WG_BAR();
        int bi = 0;
        for (int c = cbeg; c < cend; c += 2) {
            {
                const int bn = bi == 2 ? 0 : bi + 1, bp = bi == 0 ? 2 : bi - 1;
                I_STORE(imA, itA, bn); if (c + 3 < cend) I_LOAD(imA, itA, c + 3);
                if (c > cbeg) H_POST(gO, c - 1, bp);
                H_GLOAD(gO, c + 1);
                bi = bn;
                WG_BAR();
            }
            {
                const int bn = bi == 2 ? 0 : bi + 1, bp = bi == 0 ? 2 : bi - 1;
                if (c + 2 < cend) { I_STORE(imB, itB, bn); if (c + 4 < cend) I_LOAD(imB, itB, c + 4); }
                H_POST(gE, c, bp);
                if (c + 2 < cend) H_GLOAD(gE, c + 2);
                bi = bn;
                WG_BAR();
            }
        }
        H_POST(gO, cend - 1, (bi == 0 ? 2 : bi - 1));
#undef I_LOAD
#undef I_STORE
#undef H_GLOAD
#undef H_POST
    }
    WG_BAR();
}

__device__ __forceinline__ void phase5(const Args& a, int wave, int lane) {
    const float* x = a.in[0]; const float* g = a.in[5];
    const float* mod = (const float*)(a.ws + WS_MOD); const bf16* MO = (const bf16*)(a.ws + WS_MIXOUT);
    const int gw = blockIdx.x * NWAVES + wave, NGW = gridDim.x * NWAVES;
    for (int m = gw; m < M; m += NGW) {
        const int b = m >> 11;
        const v4u* mr = (const v4u*)(MO + (size_t)m * D) + lane;
        const f32x4* xr = (const f32x4*)(x + (size_t)m * D);
        v4u mv[4]; f32x4 xv[8]; float ss = 0.f;
#pragma unroll
        for (int j = 0; j < 4; ++j) mv[j] = mr[64 * j];
#pragma unroll
        for (int j = 0; j < 4; ++j) { xv[2 * j] = xr[128 * j + 2 * lane]; xv[2 * j + 1] = xr[128 * j + 2 * lane + 1]; }
#pragma unroll
        for (int j = 0; j < 4; ++j)
#pragma unroll
            for (int e = 0; e < 4; ++e) { const float lo = bflo(mv[j][e]), hi = bfhi(mv[j][e]); ss += lo * lo + hi * hi; }
        const float rinv = rsqrtf(wave_sum(ss) * (1.f / D) + 1e-6f);
        f32x4* orow = (f32x4*)(a.out + (size_t)m * D);
#pragma unroll
        for (int j = 0; j < 4; ++j)
#pragma unroll
            for (int h = 0; h < 2; ++h) {
                const int col = 512 * j + 8 * lane + 4 * h;
                const f32x4 g4 = *(const f32x4*)(g + col);
                const f32x4 gt = *(const f32x4*)(mod + b * 6144 + 4096 + col);
                const f32x4 v = (f32x4){bflo(mv[j][2 * h]), bfhi(mv[j][2 * h]), bflo(mv[j][2 * h + 1]), bfhi(mv[j][2 * h + 1])};
                orow[128 * j + 2 * lane + h] = xv[2 * j + h] + gt * (v * rinv * g4);
            }
    }
}

__device__ __forceinline__ void sub_barrier(unsigned* cnt, unsigned expect) {
    asm volatile("s_waitcnt vmcnt(0)" ::: "memory");
    __syncthreads();
    if (threadIdx.x == 0) {
        __builtin_amdgcn_fence(__ATOMIC_RELEASE, "agent");
        asm volatile("s_waitcnt vmcnt(0)" ::: "memory");
        __hip_atomic_fetch_add(cnt, 1u, __ATOMIC_RELAXED, __HIP_MEMORY_SCOPE_AGENT);
        unsigned sp = 0;
        while (__hip_atomic_load(cnt, __ATOMIC_RELAXED, __HIP_MEMORY_SCOPE_AGENT) < expect) { __builtin_amdgcn_s_sleep(2); if (++sp > (1u << 22)) break; }
        __builtin_amdgcn_fence(__ATOMIC_ACQUIRE, "agent");
        asm volatile("s_waitcnt vmcnt(0)" ::: "memory");
    }
    __syncthreads();
}

__global__ void __launch_bounds__(NWAVES * 64, 2) hymba_fwd(Args a) {
    extern __shared__ __attribute__((aligned(16))) unsigned char lds_raw[];
    LAS unsigned char* lds = (LAS unsigned char*)lds_raw;
    cg::grid_group grid = cg::this_grid();
    volatile LAS unsigned* xst = (volatile LAS unsigned*)(lds + 131072 + 512);
    if (threadIdx.x < 2) xst[threadIdx.x] = 0u;
    __syncthreads();
    const XcdBarrier xbar = xcd_barrier_post((unsigned*)(a.ws + WS_CTL), xst);
#define GRID_SYNC_CG() do { asm volatile("s_waitcnt vmcnt(0)" ::: "memory"); grid.sync(); } while (0)
#define GRID_SYNC() xcd_barrier(xbar)
    const int tid = threadIdx.x, lane = tid & 63, wave = __builtin_amdgcn_readfirstlane(tid >> 6);

    if (a.out == nullptr) GRID_SYNC_CG();
    phase0(lds, a, tid, wave, lane);
    GRID_SYNC();
    phase1(a, wave, lane);
    GRID_SYNC();
    {
        pg8::Gemm g{(const pg8::bf16_t*)(a.ws + WS_H), (const pg8::bf16_t*)(a.ws + WS_WIN), M, NP, D};
        pg8::StaticOrder S; S.init(M, NP, (int)gridDim.x, (int)blockIdx.x);
        pg8::EpiBf16<0> E{(pg8::bf16_t*)(a.ws + WS_PROJ), NP, nullptr, 0, 0, 1.f};
        pg8::gemm_phase<pg8::EpiBf16<0>, pg8::StaticOrder, true, true>(lds, g, S, E);
    }
    if (blockIdx.x >= 192) {
        mod_cols(lds, a, 128 + (int)blockIdx.x - 192, tid);
        LAS float* scr = (LAS float*)(lds + wave * 16384);
        constexpr int I_OUT2 = (D / 64) * (D / 32);
        for (int it = ((int)blockIdx.x - 192) * NWAVES + wave; it < I_OUT2; it += 64 * NWAVES) p0_transpose_item(a.in[7], D, D, (bf16*)(a.ws + WS_WOUT), scr, it, lane);
    }
    GRID_SYNC();
    phase25(a, wave, lane);
    GRID_SYNC();
    rwkv_prepass(lds, a, tid, wave, lane, 0, 64, 256, (int)blockIdx.x);
    GRID_SYNC();
    if (blockIdx.x < 128) {
        f32x4 st[4];
#pragma unroll
        for (int q = 0; q < 4; ++q) st[q] = (f32x4){0.f, 0.f, 0.f, 0.f};
#pragma unroll
        for (int sp = 0; sp < 2; ++sp) {
            int bxo = (int)blockIdx.x; asm volatile("" : "+s"(bxo));
            rwkv_block(lds, a, bxo, 64 * sp, 64 * sp + 64, st, tid, wave, lane);
            GRID_SYNC();
        }
    } else {
        const bf16* P = (const bf16*)(a.ws + WS_PROJ); bf16* mix = (bf16*)(a.ws + WS_H);
        {   int bxo = (int)blockIdx.x - 128; asm volatile("" : "+s"(bxo));
            rwkv_prepass(lds, a, tid, wave, lane, 64, 64, 128, bxo);
            GRID_SYNC(); }
        {   int bxo = (int)blockIdx.x - 128; asm volatile("" : "+s"(bxo));
            attn_phase(lds, P, mix, a.in[8], bxo, 128, 4, tid, wave, lane);
            GRID_SYNC(); }
    }
#pragma unroll
    for (int rr2 = 0; rr2 < 2; ++rr2) {
        pg8::Gemm g{(const pg8::bf16_t*)(a.ws + WS_H), (const pg8::bf16_t*)(a.ws + WS_WOUT), M, D, D};
        pg8::PanelOrder S{rr2, (int)blockIdx.x};
        pg8::EpiRmsRes E{a.in[0], a.out, a.in[5], (const float*)(a.ws + WS_MOD), (unsigned*)(a.ws + WS_XW), (unsigned*)(a.ws + WS_CTL + 16384)};
        pg8::gemm_phase<pg8::EpiRmsRes, pg8::PanelOrder, false, true>(lds, g, S, E);
    }
}

extern "C" void kernel_launch(void* const* d_in, const int* in_sizes, int n_in, void* d_out, int out_size, void* d_ws, size_t ws_size, hipStream_t stream) {
    static int grid = 0;
    if (grid == 0) {
        if (n_in != 19 || out_size != M * D || ws_size < WS_END) { fprintf(stderr, "kernel_launch: unexpected shapes (n_in %d out %d ws %zu)\n", n_in, out_size, ws_size); grid = -1; return; }
        int dev = 0, cus = 0, per_cu = 0;
        (void)hipGetDevice(&dev); (void)hipDeviceGetAttribute(&cus, hipDeviceAttributeMultiprocessorCount, dev);
        (void)hipFuncSetAttribute((const void*)hymba_fwd, hipFuncAttributeMaxDynamicSharedMemorySize, LDS_BYTES);
        (void)hipOccupancyMaxActiveBlocksPerMultiprocessor(&per_cu, (const void*)hymba_fwd, NWAVES * 64, LDS_BYTES);
        (void)hipGetLastError();
        grid = cus > 0 ? cus : 256;
        if (per_cu < 1) fprintf(stderr, "kernel_launch: occupancy query says %d blocks per CU\n", per_cu);
    }
    if (grid < 0) return;
    if (hipMemsetAsync((char*)d_ws + WS_CTL, 0, CTL_BYTES, stream) != hipSuccess) { fprintf(stderr, "kernel_launch: memset of the barrier words failed\n"); return; }
    Args a{};
    for (int i = 0; i < 19; ++i) a.in[i] = (const float*)d_in[i];
    a.out = (float*)d_out; a.ws = (unsigned char*)d_ws;
    void* args[] = {&a};
    hipError_t e = hipLaunchCooperativeKernel((const void*)hymba_fwd, dim3(grid), dim3(NWAVES * 64), args, LDS_BYTES, stream);
    if (e != hipSuccess) fprintf(stderr, "cooperative launch failed: %s (grid %d)\n", hipGetErrorString(e), grid);
}
```
